# Optimizing an MI355X kernel written in HIP

```python
import math
import jax, jax.numpy as jnp
from jax import lax
import numpy as np

D_MODEL = 1024
BATCH = 4
SEQ = 4096
DEPTH = 4

GRID_W = 64
CTX_LEN = 256
N_MIXERS = 2
N_RET_LAYERS = (DEPTH + 1) // 2
N_DIFF_LAYERS = DEPTH // 2
RET_HEADS = 4
RET_DK = D_MODEL // RET_HEADS
RET_DV = 2 * RET_DK
RET_CHUNK = 128
RET_IN = 2 * RET_HEADS * RET_DK + 3 * RET_HEADS * RET_DV
DIFF_HEADS = 8
DIFF_D = D_MODEL // (2 * DIFF_HEADS)
DIFF_Q_BLOCK = 128
FFN_HIDDEN = ((8 * D_MODEL // 3 + 127) // 128) * 128
CONV_W = 3
ROPE_BASE = 10000.0
EPS = 1e-6

kernel_name = "hybrid_retention_diffattn_dit"


def rms_norm(x, g):
    x32 = x.astype(jnp.float32)
    y = x32 * lax.rsqrt(jnp.mean(x32 * x32, axis=-1, keepdims=True) + EPS)
    return (y * g.astype(jnp.float32)).astype(x.dtype)


def head_norm(x):
    x32 = x.astype(jnp.float32)
    return x32 * lax.rsqrt(jnp.mean(x32 * x32, axis=-1, keepdims=True) + EPS)


def ada_mod(cvec, w, b):
    m = jax.nn.silu(cvec) @ w + b
    return jnp.split(m[:, None, :], 6, axis=-1)


def modulate(xn, shift, scale):
    return xn * (1 + scale) + shift


def grid_positions(n):
    rows = n // GRID_W
    row = jnp.repeat(jnp.arange(rows, dtype=jnp.float32), GRID_W)
    col = jnp.tile(jnp.arange(GRID_W, dtype=jnp.float32), rows)
    return row, col


def rope_1d(x, pos):
    d2 = x.shape[-1]
    inv = ROPE_BASE ** (-jnp.arange(0, d2, 2, dtype=jnp.float32) / d2)
    ang = pos[:, None] * inv[None, :]
    cos, sin = jnp.cos(ang), jnp.sin(ang)
    x32 = x.astype(jnp.float32)
    x1, x2 = x32[..., : d2 // 2], x32[..., d2 // 2:]
    return jnp.concatenate([x1 * cos - x2 * sin, x1 * sin + x2 * cos], axis=-1).astype(x.dtype)


def rope_2d(x, row, col):
    half = x.shape[-1] // 2
    return jnp.concatenate([rope_1d(x[..., :half], row), rope_1d(x[..., half:], col)], axis=-1)


def split_heads(t, h, d):
    b, n = t.shape[0], t.shape[1]
    return t.reshape(b, n, h, d).transpose(0, 2, 1, 3)


def merge_heads(t):
    b, h, n, d = t.shape
    return t.transpose(0, 2, 1, 3).reshape(b, n, h * d)


def retention_scan(q, k, v, log_gamma, r0):
    b, h, n, dk = q.shape
    dv = v.shape[-1]
    nc = n // RET_CHUNK
    q, k, v = q.astype(jnp.float32), k.astype(jnp.float32), v.astype(jnp.float32)
    idx = jnp.arange(RET_CHUNK, dtype=jnp.float32)
    diff = idx[:, None] - idx[None, :]
    lg = log_gamma.astype(jnp.float32)
    dmask = jnp.where(diff >= 0, jnp.exp(lg[:, None, None] * jnp.maximum(diff, 0.0)), 0.0)
    xi = jnp.exp(lg[:, None] * (idx + 1.0))[None, :, :, None]
    zeta = jnp.exp(lg[:, None] * (RET_CHUNK - 1.0 - idx))[None, :, :, None]
    chunk_decay = jnp.exp(lg * RET_CHUNK)[None, :, None, None]

    def step(r, qkv):
        qc, kc, vc = qkv
        s = jnp.einsum('bhid,bhjd->bhij', qc, kc) * dmask
        o = jnp.einsum('bhij,bhjv->bhiv', s, vc) + jnp.einsum('bhid,bhdv->bhiv', qc, r) * xi
        r = r * chunk_decay + jnp.einsum('bhjd,bhjv->bhdv', kc * zeta, vc)
        return r, o

    def to_chunks(t):
        return jnp.moveaxis(t.reshape(b, h, nc, RET_CHUNK, t.shape[-1]), 2, 0)

    r, o = lax.scan(step, r0, (to_chunks(q), to_chunks(k), to_chunks(v)))
    return jnp.moveaxis(o, 0, 2).reshape(b, h, n, dv), r


def retention_mixer(hx, hc, w_in, w_out, logit_f, logit_b, need_ctx):
    hdk, hdv = RET_HEADS * RET_DK, RET_HEADS * RET_DV

    def proj(u):
        p = u @ w_in
        q, k, v, gf, gb = jnp.split(p, [hdk, 2 * hdk, 2 * hdk + hdv, 2 * hdk + 2 * hdv], axis=-1)
        return (split_heads(q, RET_HEADS, RET_DK), split_heads(k, RET_HEADS, RET_DK) * (RET_DK ** -0.5),
                split_heads(v, RET_HEADS, RET_DV), gf, gb)

    qx, kx, vx, gfx, gbx = proj(hx)
    qc, kc, vc, gfc, gbc = proj(hc)
    row, col = grid_positions(hx.shape[1])
    qx, kx = rope_2d(qx, row, col), rope_2d(kx, row, col)
    lg_f = jax.nn.log_sigmoid(logit_f.astype(jnp.float32))
    lg_b = jax.nn.log_sigmoid(logit_b.astype(jnp.float32))
    r0 = jnp.zeros((hx.shape[0], RET_HEADS, RET_DK, RET_DV), jnp.float32)
    flip = lambda t: jnp.flip(t, axis=2)
    oc_f, rc_f = retention_scan(qc, kc, vc, lg_f, r0)
    oc_b, rc_b = retention_scan(flip(qc), flip(kc), flip(vc), lg_b, r0)
    ox_f, _ = retention_scan(qx, kx, vx, lg_f, rc_f)
    ox_b, _ = retention_scan(flip(qx), flip(kx), flip(vx), lg_b, rc_b)

    def merge(of, ob, gf, gb, dt):
        y = (jax.nn.silu(gf.astype(jnp.float32)) * merge_heads(head_norm(of))
             + jax.nn.silu(gb.astype(jnp.float32)) * merge_heads(head_norm(ob)))
        return y.astype(dt) @ w_out

    yx = merge(ox_f, flip(ox_b), gfx, gbx, hx.dtype)
    yc = merge(oc_f, flip(oc_b), gfc, gbc, hc.dtype) if need_ctx else None
    return yx, yc


def diff_attend(q1, q2, k1, k2, v, lam):
    b, h, n, d = q1.shape
    nb = n // DIFF_Q_BLOCK
    scale = d ** -0.5

    def to_blocks(t):
        return jnp.moveaxis(t.reshape(b, h, nb, DIFF_Q_BLOCK, d), 2, 0)

    def one(qs):
        a, c = qs
        s1 = jnp.einsum('bhqd,bhkd->bhqk', a, k1).astype(jnp.float32) * scale
        s2 = jnp.einsum('bhqd,bhkd->bhqk', c, k2).astype(jnp.float32) * scale
        p = jax.nn.softmax(s1, axis=-1) - lam * jax.nn.softmax(s2, axis=-1)
        return jnp.einsum('bhqk,bhkv->bhqv', p.astype(v.dtype), v)

    o = lax.map(one, (to_blocks(q1), to_blocks(q2)))
    return jnp.moveaxis(o, 0, 2).reshape(b, h, n, v.shape[-1])


def diff_mixer(hx, hc, w_in, w_out, lq1, lk1, lq2, lk2, subln_g, lam_init, need_ctx):
    def proj(u):
        bsz, n = u.shape[0], u.shape[1]
        p = u @ w_in
        q, k, v = jnp.split(p, [D_MODEL, 2 * D_MODEL], axis=-1)
        q = q.reshape(bsz, n, DIFF_HEADS, 2, DIFF_D).transpose(0, 2, 3, 1, 4)
        k = k.reshape(bsz, n, DIFF_HEADS, 2, DIFF_D).transpose(0, 2, 3, 1, 4)
        v = split_heads(v, DIFF_HEADS, 2 * DIFF_D)
        return q[:, :, 0], q[:, :, 1], k[:, :, 0], k[:, :, 1], v

    q1x, q2x, k1x, k2x, vx = proj(hx)
    q1c, q2c, k1c, k2c, vc = proj(hc)
    row, col = grid_positions(hx.shape[1])
    q1x, q2x = rope_2d(q1x, row, col), rope_2d(q2x, row, col)
    k1x, k2x = rope_2d(k1x, row, col), rope_2d(k2x, row, col)
    lam = (jnp.exp(jnp.sum(lq1.astype(jnp.float32) * lk1.astype(jnp.float32)))
           - jnp.exp(jnp.sum(lq2.astype(jnp.float32) * lk2.astype(jnp.float32))) + lam_init)
    k1a = jnp.concatenate([k1x, k1c], axis=2)
    k2a = jnp.concatenate([k2x, k2c], axis=2)
    va = jnp.concatenate([vx, vc], axis=2)

    def post(o):
        return merge_heads(rms_norm(o, subln_g) * (1.0 - lam_init)) @ w_out

    yx = post(diff_attend(q1x, q2x, k1a, k2a, va, lam))
    yc = post(diff_attend(q1c, q2c, k1c, k2c, vc, lam)) if need_ctx else None
    return yx, yc


def dwconv3(x, w, b):
    xp = jnp.pad(x, ((0, 0), (1, 1), (0, 0)))
    return xp[:, :-2] * w[0] + xp[:, 1:-1] * w[1] + xp[:, 2:] * w[2] + b


def conv_ffn(u, w_up, conv_w, conv_b, w_down):
    val, gate = jnp.split(u @ w_up, 2, axis=-1)
    return (jax.nn.silu(dwconv3(gate, conv_w, conv_b)) * val) @ w_down


def setup_inputs(seed: int = 0) -> dict:
    key = jax.random.key(seed)
    ks = jax.random.split(key, 24)
    f32 = jnp.float32
    nrm = lambda k, s, sc: jax.random.normal(k, s, f32) * sc
    base_logit = jnp.log(2.0 ** (5.0 + jnp.arange(RET_HEADS, dtype=f32)) - 1.0)
    return {
        "x": nrm(ks[0], (BATCH, SEQ, D_MODEL), 1.0),
        "c": nrm(ks[1], (BATCH, D_MODEL), 1.0),
        "ctx": nrm(ks[2], (BATCH, CTX_LEN, D_MODEL), 1.0),
        "c_ctx": nrm(ks[3], (D_MODEL,), 1.0),
        "ada_w": nrm(ks[4], (DEPTH, D_MODEL, 6 * D_MODEL), 0.5 * D_MODEL ** -0.5),
        "ada_b": nrm(ks[5], (DEPTH, 6 * D_MODEL), 0.02),
        "norm_g": 1.0 + nrm(ks[6], (DEPTH, 4, D_MODEL), 0.1),
        "ret_w_in": nrm(ks[7], (N_RET_LAYERS, D_MODEL, RET_IN), D_MODEL ** -0.5),
        "ret_w_out": nrm(ks[8], (N_RET_LAYERS, RET_HEADS * RET_DV, D_MODEL), (RET_HEADS * RET_DV) ** -0.5),
        "ret_decay_f": base_logit + nrm(ks[9], (N_RET_LAYERS, RET_HEADS), 0.05),
        "ret_decay_b": base_logit + nrm(ks[10], (N_RET_LAYERS, RET_HEADS), 0.05),
        "diff_w_in": nrm(ks[11], (N_DIFF_LAYERS, D_MODEL, 3 * D_MODEL), D_MODEL ** -0.5),
        "diff_w_out": nrm(ks[12], (N_DIFF_LAYERS, D_MODEL, D_MODEL), D_MODEL ** -0.5),
        "diff_lq1": nrm(ks[13], (N_DIFF_LAYERS, DIFF_D), 0.1),
        "diff_lk1": nrm(ks[14], (N_DIFF_LAYERS, DIFF_D), 0.1),
        "diff_lq2": nrm(ks[15], (N_DIFF_LAYERS, DIFF_D), 0.1),
        "diff_lk2": nrm(ks[16], (N_DIFF_LAYERS, DIFF_D), 0.1),
        "diff_subln": 1.0 + nrm(ks[17], (N_DIFF_LAYERS, 2 * DIFF_D), 0.1),
        "ffn_w_up": nrm(ks[18], (DEPTH, D_MODEL, 2 * FFN_HIDDEN), D_MODEL ** -0.5),
        "ffn_conv_w": nrm(ks[19], (DEPTH, CONV_W, FFN_HIDDEN), CONV_W ** -0.5),
        "ffn_conv_b": nrm(ks[20], (DEPTH, FFN_HIDDEN), 0.02),
        "ffn_w_down": nrm(ks[21], (DEPTH, FFN_HIDDEN, D_MODEL), FFN_HIDDEN ** -0.5),
    }


def reference(x, c, ctx, c_ctx, ada_w, ada_b, norm_g, ret_w_in, ret_w_out, ret_decay_f, ret_decay_b,
              diff_w_in, diff_w_out, diff_lq1, diff_lk1, diff_lq2, diff_lk2, diff_subln,
              ffn_w_up, ffn_conv_w, ffn_conv_b, ffn_w_down):
    h_x, h_c = x, ctx
    for l in range(DEPTH):
        last = l == DEPTH - 1
        shm, scm, gm, shf, scf, gf = ada_mod(c, ada_w[l], ada_b[l])
        cshm, cscm, cgm, cshf, cscf, cgf = ada_mod(c_ctx[None, :], ada_w[l], ada_b[l])
        ux = modulate(rms_norm(h_x, norm_g[l, 0]), shm, scm)
        uc = modulate(rms_norm(h_c, norm_g[l, 0]), cshm, cscm)
        i = l // N_MIXERS
        if l % N_MIXERS == 0:
            yx, yc = retention_mixer(ux, uc, ret_w_in[i], ret_w_out[i], ret_decay_f[i], ret_decay_b[i],
                                     not last)
        else:
            lam_init = 0.8 - 0.6 * math.exp(-0.3 * l)
            yx, yc = diff_mixer(ux, uc, diff_w_in[i], diff_w_out[i], diff_lq1[i], diff_lk1[i],
                                diff_lq2[i], diff_lk2[i], diff_subln[i], lam_init, not last)
        h_x = h_x + gm * rms_norm(yx, norm_g[l, 1])
        fx = conv_ffn(modulate(rms_norm(h_x, norm_g[l, 2]), shf, scf),
                      ffn_w_up[l], ffn_conv_w[l], ffn_conv_b[l], ffn_w_down[l])
        h_x = h_x + gf * rms_norm(fx, norm_g[l, 3])
        if not last:
            h_c = h_c + cgm * rms_norm(yc, norm_g[l, 1])
            fc = conv_ffn(modulate(rms_norm(h_c, norm_g[l, 2]), cshf, cscf),
                          ffn_w_up[l], ffn_conv_w[l], ffn_conv_b[l], ffn_w_down[l])
            h_c = h_c + cgf * rms_norm(fc, norm_g[l, 3])
    return h_x
```

```cpp
#include <hip/hip_runtime.h>
#include <hip/hip_cooperative_groups.h>
#include <cstdio>
#include <cstdint>
namespace cg = cooperative_groups;

#ifndef MULTI_LAUNCH
#define MULTI_LAUNCH 0
#endif

typedef unsigned short bf16_t;
typedef short bf16x8 __attribute__((ext_vector_type(8)));
typedef short s16x4 __attribute__((ext_vector_type(4)));
typedef float f32x16 __attribute__((ext_vector_type(16)));
typedef float f32x4 __attribute__((ext_vector_type(4)));
typedef float f32x2 __attribute__((ext_vector_type(2)));
typedef unsigned u32x4 __attribute__((ext_vector_type(4)));
typedef unsigned u32x2 __attribute__((ext_vector_type(2)));
typedef __bf16 bf2_t __attribute__((ext_vector_type(2)));

#define DI __device__ __forceinline__
typedef __attribute__((address_space(3))) unsigned lds_u32_t;
#define GLDS(gp, lp) __builtin_amdgcn_global_load_lds((const unsigned*)(gp), (lds_u32_t*)(lp), 16, 0, 0)
#define MFMA(a, b, c) __builtin_amdgcn_mfma_f32_32x32x16_bf16((a), (b), (c), 0, 0, 0)

constexpr int T = 17408, TL = 16384, DM = 1024, NTH = 256;
constexpr float EPS = 1e-6f;
constexpr size_t SZ_U = (size_t)T * 1024 * 2;
constexpr size_t OFF_MOD = 0;
constexpr size_t OFF_TABR = OFF_MOD + 4 * 5 * 6144 * 4;
constexpr size_t OFF_TABD = OFF_TABR + 64 * 64 * 8;
constexpr size_t OFF_SSQ = OFF_TABD + 64 * 16 * 8;
constexpr size_t OFF_HC = OFF_SSQ + (size_t)T * 64 * 4 * 2;
constexpr size_t OFF_U = OFF_HC + 1024 * 1024 * 4;
constexpr size_t OFF_WM = OFF_U + SZ_U;
constexpr size_t OFF_WF = OFF_WM + (size_t)8192 * 1024 * 2 + (size_t)1024 * 2048 * 2;
constexpr size_t OFF_AR = OFF_WF + (size_t)5632 * 1024 * 2 + (size_t)1024 * 2816 * 2;
constexpr size_t OFF_BAR = OFF_AR + 9 * SZ_U;
constexpr size_t WS_NEED = OFF_BAR + 16384;

struct Params {
  const float *x, *c, *ctx, *c_ctx, *ada_w, *ada_b, *norm_g, *ret_w_in, *ret_w_out, *ret_df, *ret_db;
  const float *diff_w_in, *diff_w_out, *lq1, *lk1, *lq2, *lk2, *subln, *ffn_up, *ffn_cw, *ffn_cb, *ffn_down;
  float* out; char* ws; int lo, hi;
};

DI unsigned pk2(float lo, float hi) { f32x2 v = {lo, hi}; bf2_t b = __builtin_convertvector(v, bf2_t); return __builtin_bit_cast(unsigned, b); }
DI bf16_t f2bf(float x) { return (bf16_t)(pk2(x, 0.f) & 0xffffu); }
DI float bflo(unsigned u) { return __uint_as_float(u << 16); }
DI float bfhi(unsigned u) { return __uint_as_float(u & 0xffff0000u); }
DI float bf2f(bf16_t x) { return __uint_as_float((unsigned)x << 16); }
DI int crow(int reg, int h) { return (reg & 3) + 8 * (reg >> 2) + 4 * h; }
DI float ex2(float x) { return __builtin_amdgcn_exp2f(x); }
DI float wsum(float v) { for (int m = 32; m >= 1; m >>= 1) v += __shfl_xor(v, m); return v; }
DI float siluf(float x) { return x * __builtin_amdgcn_rcpf(1.f + __expf(-x)); }
DI bf16x8 pack8(const f32x16& x, int s) {
  u32x4 p; p.x = pk2(x[8 * s], x[8 * s + 1]); p.y = pk2(x[8 * s + 2], x[8 * s + 3]); p.z = pk2(x[8 * s + 4], x[8 * s + 5]); p.w = pk2(x[8 * s + 6], x[8 * s + 7]);
  return __builtin_bit_cast(bf16x8, p);
}
DI int lane_id() { return (int)__builtin_amdgcn_mbcnt_hi(~0u, __builtin_amdgcn_mbcnt_lo(~0u, 0u)); }
DI int otid_w(int wid_s) { int t = (wid_s << 6) | lane_id(); asm volatile("" : "+v"(t)); return t; }
#define otid() otid_w(wid_s)
DI f32x2 rope_cs(int pos, int fi, float cexp) {
  const float ang = (float)pos * ex2(-(float)fi * cexp);
  const float rev = ang * 0.15915494309189535f;
  const float fr = rev - rintf(rev);
  f32x2 cs; cs.x = __builtin_amdgcn_cosf(fr); cs.y = __builtin_amdgcn_sinf(fr); return cs;
}
#define XB_TMO      128
#define XB_XCNT(j)  (256  + 64 * (j))
#define XB_XSUB(j)  (1280 + 64 * (j))
#define XB_XGEN(j)  (2304 + 64 * (j))
#define XB_TOP      3328
#define XB_TOPGEN   3392
#define XB_SPIN_CAP (1u << 22)
#define LAS __attribute__((address_space(3)))
DI unsigned xb_ld(unsigned* p) { return __hip_atomic_load(p, __ATOMIC_RELAXED, __HIP_MEMORY_SCOPE_AGENT); }
DI unsigned xb_add(unsigned* p, unsigned v) { return __hip_atomic_fetch_add(p, v, __ATOMIC_RELAXED, __HIP_MEMORY_SCOPE_AGENT); }
DI unsigned xb_xcc_id() { return (unsigned)__builtin_amdgcn_s_getreg((3 << 11) | 20) & 0xFu; }
#define XB_SPIN(cond, bar) do { unsigned _sp = 0; while (cond) { __builtin_amdgcn_s_sleep(1); \
    if ((++_sp & 255u) == 0u) { if (xb_ld(&(bar)[XB_TMO])) break; if (_sp > XB_SPIN_CAP) { atomicAdd(&(bar)[XB_TMO], 1u); break; } } } } while (0)
struct XcdBarrier { unsigned* bar; unsigned x; volatile LAS unsigned* st; };
DI XcdBarrier xcd_barrier_post(unsigned* bar, volatile LAS unsigned* st, int wid_s) {
  XcdBarrier b; b.bar = bar; b.x = xb_xcc_id(); b.st = st;
  if (wid_s == 0 && lane_id() == 0) (void)xb_add(&bar[XB_XCNT(b.x)], 1u);
  return b;
}
DI void xcd_barrier_complete(unsigned* bar, unsigned x, unsigned& nloc, unsigned& nx) {
  const unsigned G = gridDim.x;
  unsigned sum, cnt, mine, sp = 0u;
  for (;;) {
    sum = 0u; cnt = 0u; mine = 0u;
#pragma unroll
    for (unsigned j = 0; j < 16; ++j) { const unsigned c = xb_ld(&bar[XB_XCNT(j)]); sum += c; cnt += (c > 0u) ? 1u : 0u; mine = (j == x) ? c : mine; }
    if (sum == G) break;
    __builtin_amdgcn_s_sleep(1);
    if ((++sp & 255u) == 0u) { if (xb_ld(&bar[XB_TMO])) break; if (sp > XB_SPIN_CAP) { atomicAdd(&bar[XB_TMO], 1u); break; } }
  }
  nloc = mine > 0u ? mine : 1u; nx = cnt > 0u ? cnt : 1u;
}
DI void xcd_barrier(const XcdBarrier& b, int wid_s) {
  asm volatile("s_waitcnt vmcnt(0)" ::: "memory");
  __syncthreads();
  if (wid_s == 0 && lane_id() == 0) {
    unsigned* bar = b.bar;
    __builtin_amdgcn_s_waitcnt(0);
    unsigned nloc = b.st[0], nx = b.st[1];
    if (nloc == 0u) { xcd_barrier_complete(bar, b.x, nloc, nx); b.st[0] = nloc; b.st[1] = nx; }
    const unsigned old = xb_add(&bar[XB_XSUB(b.x)], 1u);
    const unsigned gen = old / nloc;
    if (old + 1u == (gen + 1u) * nloc) {
      __builtin_amdgcn_fence(__ATOMIC_RELEASE, "agent");
      asm volatile("s_waitcnt vmcnt(0)" ::: "memory");
      const unsigned og = xb_add(&bar[XB_TOP], 1u);
      const unsigned tg = og / nx;
      if (og + 1u == (tg + 1u) * nx) xb_add(&bar[XB_TOPGEN], 1u);
      else XB_SPIN(xb_ld(&bar[XB_TOPGEN]) == tg, bar);
      __builtin_amdgcn_fence(__ATOMIC_ACQUIRE, "agent");
      xb_add(&bar[XB_XGEN(b.x)], 1u);
      asm volatile("s_waitcnt vmcnt(0)" ::: "memory");
    } else {
      XB_SPIN(xb_ld(&bar[XB_XGEN(b.x)]) == gen, bar);
      __builtin_amdgcn_fence(__ATOMIC_ACQUIRE, "agent");
      asm volatile("s_waitcnt vmcnt(0)" ::: "memory");
    }
  }
  __syncthreads();
}
template <int CTRL> DI float dpp_xadd(float x) { return x + __int_as_float(__builtin_amdgcn_update_dpp(0, __float_as_int(x), CTRL, 0xF, 0xF, true)); }
DI int rowbsel(int row) { return row < TL ? (row >> 12) : 4; }

DI int srccol(int g, int mode) {
  if (mode == 1) {
    if (g < 2048) return (g & ~127) + 32 * ((g >> 6) & 1) + (g & 31) + 64 * ((g >> 5) & 1);
    if (g < 4096) return g;
    int gp = g - 4096; return 4096 + 2048 * ((gp >> 5) & 1) + 32 * (gp >> 6) + (gp & 31);
  }
  if (mode == 2) {
    if (g < 2048) { int c = g & 31; return (g & ~63) + (c < 16 ? c : c + 16) + 16 * ((g >> 5) & 1); }
    return g;
  }
  if (mode == 3) return 64 * (g >> 7) + (g & 63) + 2816 * ((g >> 6) & 1);
  return g;
}
DI void conv_range(const float* __restrict__ src, int nsrc, bf16_t* __restrict__ dst, int K, int nrows, int mode, char* lds, int& base, int wid_s) {
  float (*tile)[65] = (float (*)[65])lds;
  const int tid = otid(), nkb = K >> 6, nitems = (nrows >> 6) * nkb, G = gridDim.x;
  int it = (int)((blockIdx.x + G - (base % G)) % G);
  float r[16];
  if (it < nitems) {
    const int g0 = (it / nkb) * 64, k0 = (it % nkb) * 64;
#pragma unroll
    for (int i = 0; i < 16; ++i) { int e = tid + 256 * i, kk = e >> 6, gg = e & 63; r[i] = src[(size_t)(k0 + kk) * nsrc + srccol(g0 + gg, mode)]; }
  }
  for (; it < nitems; it += G) {
    const int g0 = (it / nkb) * 64, k0 = (it % nkb) * 64;
#pragma unroll
    for (int i = 0; i < 16; ++i) { int e = tid + 256 * i, kk = e >> 6, gg = e & 63; tile[kk][gg] = r[i]; }
    __syncthreads();
    if (it + G < nitems) {
      const int g1 = ((it + G) / nkb) * 64, k1 = ((it + G) % nkb) * 64;
#pragma unroll
      for (int i = 0; i < 16; ++i) { int e = tid + 256 * i, kk = e >> 6, gg = e & 63; r[i] = src[(size_t)(k1 + kk) * nsrc + srccol(g1 + gg, mode)]; }
    }
    const int gg = tid >> 2, kq = (tid & 3) * 16;
    u32x4 w0, w1;
    w0.x = pk2(tile[kq + 0][gg], tile[kq + 1][gg]); w0.y = pk2(tile[kq + 2][gg], tile[kq + 3][gg]); w0.z = pk2(tile[kq + 4][gg], tile[kq + 5][gg]); w0.w = pk2(tile[kq + 6][gg], tile[kq + 7][gg]);
    w1.x = pk2(tile[kq + 8][gg], tile[kq + 9][gg]); w1.y = pk2(tile[kq + 10][gg], tile[kq + 11][gg]); w1.z = pk2(tile[kq + 12][gg], tile[kq + 13][gg]); w1.w = pk2(tile[kq + 14][gg], tile[kq + 15][gg]);
    bf16_t* d = dst + (size_t)(g0 + gg) * K + k0 + kq;
    *(u32x4*)d = w0; *(u32x4*)(d + 8) = w1;
    __syncthreads();
  }
  base += nitems;
}
DI void conv_mixer(const Params& P, int l, char* lds, int& base, int wid_s) {
  bf16_t* WM = (bf16_t*)(P.ws + OFF_WM); const int i = l >> 1;
  if ((l & 1) == 0) {
    conv_range(P.ret_w_in + (size_t)i * 1024 * 8192, 8192, WM, 1024, 8192, 1, lds, base, wid_s);
    conv_range(P.ret_w_out + (size_t)i * 2048 * 1024, 1024, WM + (size_t)8192 * 1024, 2048, 1024, 0, lds, base, wid_s);
  } else {
    conv_range(P.diff_w_in + (size_t)i * 1024 * 3072, 3072, WM, 1024, 3072, 2, lds, base, wid_s);
    conv_range(P.diff_w_out + (size_t)i * 1024 * 1024, 1024, WM + (size_t)3072 * 1024, 1024, 1024, 0, lds, base, wid_s);
  }
}
DI void conv_ffn(const Params& P, int l, char* lds, int& base, int wid_s) {
  bf16_t* WF = (bf16_t*)(P.ws + OFF_WF);
  conv_range(P.ffn_up + (size_t)l * 1024 * 5632, 5632, WF, 1024, 5632, 3, lds, base, wid_s);
  conv_range(P.ffn_down + (size_t)l * 2816 * 1024, 1024, WF + (size_t)5632 * 1024, 2816, 1024, 0, lds, base, wid_s);
}

DI void mod_phase(const Params& P, char* lds, int wid_s) {
  const int tid = otid();
  float* sc = (float*)lds; float* red = (float*)(lds + 20480);
  float* mod = (float*)(P.ws + OFF_MOD);
  for (int e = tid; e < 5120; e += NTH) { int bs = e >> 10, k = e & 1023; float v = bs < 4 ? P.c[bs * 1024 + k] : P.c_ctx[k]; sc[e] = v / (1.f + __expf(-v)); }
  __syncthreads();
  for (int item = blockIdx.x; item < 384; item += gridDim.x) {
    const int l = item / 96, cgp = item % 96, kq = tid >> 6, cl = tid & 63, col = cgp * 64 + cl;
    float a0 = 0, a1 = 0, a2 = 0, a3 = 0, a4 = 0;
    const float* w = P.ada_w + ((size_t)l * 1024 + kq * 256) * 6144 + col;
#pragma unroll 8
    for (int k = 0; k < 256; ++k) { float wv = w[(size_t)k * 6144]; int kk = kq * 256 + k; a0 += sc[kk] * wv; a1 += sc[1024 + kk] * wv; a2 += sc[2048 + kk] * wv; a3 += sc[3072 + kk] * wv; a4 += sc[4096 + kk] * wv; }
    red[(kq * 5 + 0) * 64 + cl] = a0; red[(kq * 5 + 1) * 64 + cl] = a1; red[(kq * 5 + 2) * 64 + cl] = a2; red[(kq * 5 + 3) * 64 + cl] = a3; red[(kq * 5 + 4) * 64 + cl] = a4;
    __syncthreads();
    for (int e = tid; e < 320; e += NTH) { int bs = e >> 6, c2 = e & 63; float s = red[(0 * 5 + bs) * 64 + c2] + red[(1 * 5 + bs) * 64 + c2] + red[(2 * 5 + bs) * 64 + c2] + red[(3 * 5 + bs) * 64 + c2];
      mod[(size_t)(l * 5 + bs) * 6144 + cgp * 64 + c2] = s + P.ada_b[l * 6144 + cgp * 64 + c2]; }
    __syncthreads();
  }
}

DI void pn_phase(const Params& P, int l_res, int which_res, int l_pre, int which_pre, bool h_from_input, const bf16_t* ybuf, int wid_s) {
  const int tid0 = otid(); const int lane = tid0 & 63, w = tid0 >> 6;
  const float* mod = (const float*)(P.ws + OFF_MOD);
  float* hc = (float*)(P.ws + OFF_HC); bf16_t* u = (bf16_t*)(P.ws + OFF_U);
  const int nrows = l_pre < 0 ? TL : T;
  const int nw = gridDim.x * 4;
  for (int row0 = blockIdx.x * 4 + w; row0 < nrows; row0 += 2 * nw) {
    int rows[2] = {row0, row0 + nw};
    const bool has1 = rows[1] < nrows; if (!has1) rows[1] = row0;
    const float* hin[2]; float* hout[2]; int bs[2];
    f32x4 hv[2][4], yv[2][4];
#pragma unroll
    for (int k = 0; k < 2; ++k) {
      const int row = rows[k]; bs[k] = rowbsel(row);
      hin[k] = h_from_input ? (row < TL ? P.x + (size_t)row * 1024 : P.ctx + (size_t)(row - TL) * 1024)
                            : (row < TL ? P.out + (size_t)row * 1024 : hc + (size_t)(row - TL) * 1024);
      hout[k] = row < TL ? P.out + (size_t)row * 1024 : hc + (size_t)(row - TL) * 1024;
#pragma unroll
      for (int i = 0; i < 4; ++i) hv[k][i] = *(const f32x4*)(hin[k] + lane * 4 + 256 * i);
      if (l_res >= 0) {
#pragma unroll
        for (int i = 0; i < 4; ++i) {
          if (row < TL) { const u32x2 yr = *(const u32x2*)(ybuf + (size_t)row * 1024 + lane * 4 + 256 * i); yv[k][i] = (f32x4){bflo(yr.x), bfhi(yr.x), bflo(yr.y), bfhi(yr.y)}; }
          else {
            const float* yp = (const float*)(P.ws + OFF_AR + 4 * SZ_U) + (size_t)(row - TL) * 1024 + lane * 4 + 256 * i;
            yv[k][i] = (*(const f32x4*)yp + *(const f32x4*)(yp + 1024 * 1024)) + (*(const f32x4*)(yp + 2 * 1024 * 1024) + *(const f32x4*)(yp + 3 * 1024 * 1024));
          }
        }
      }
    }
#pragma unroll
    for (int k = 0; k < 2; ++k) {
      if (k == 1 && !has1) break;
      const int row = rows[k];
      if (l_res >= 0) {
        float ss = 0.f;
#pragma unroll
        for (int i = 0; i < 4; ++i) ss += yv[k][i].x * yv[k][i].x + yv[k][i].y * yv[k][i].y + yv[k][i].z * yv[k][i].z + yv[k][i].w * yv[k][i].w;
        ss = wsum(ss); const float rstd = rsqrtf(ss * (1.f / 1024.f) + EPS);
        const float* gate = mod + (size_t)(l_res * 5 + bs[k]) * 6144 + (which_res ? 5 : 2) * 1024;
        const float* gp = P.norm_g + (size_t)(l_res * 4 + (which_res ? 3 : 1)) * 1024;
#pragma unroll
        for (int i = 0; i < 4; ++i) { f32x4 gt = *(const f32x4*)(gate + lane * 4 + 256 * i), gg = *(const f32x4*)(gp + lane * 4 + 256 * i); hv[k][i] += gt * (yv[k][i] * rstd * gg); *(f32x4*)(hout[k] + lane * 4 + 256 * i) = hv[k][i]; }
      }
      if (l_pre >= 0) {
        float ss = 0.f;
#pragma unroll
        for (int i = 0; i < 4; ++i) ss += hv[k][i].x * hv[k][i].x + hv[k][i].y * hv[k][i].y + hv[k][i].z * hv[k][i].z + hv[k][i].w * hv[k][i].w;
        ss = wsum(ss); const float rstd = rsqrtf(ss * (1.f / 1024.f) + EPS);
        const float* g = P.norm_g + (size_t)(l_pre * 4 + (which_pre ? 2 : 0)) * 1024;
        const float* sh = mod + (size_t)(l_pre * 5 + bs[k]) * 6144 + (which_pre ? 3 : 0) * 1024;
        const float* scv = mod + (size_t)(l_pre * 5 + bs[k]) * 6144 + (which_pre ? 4 : 1) * 1024;
#pragma unroll
        for (int i = 0; i < 4; ++i) {
          f32x4 gg = *(const f32x4*)(g + lane * 4 + 256 * i), s1 = *(const f32x4*)(sh + lane * 4 + 256 * i), s2 = *(const f32x4*)(scv + lane * 4 + 256 * i);
          f32x4 o = (hv[k][i] * rstd * gg) * (s2 + 1.f) + s1;
          u32x2 pk; pk.x = pk2(o.x, o.y); pk.y = pk2(o.z, o.w);
          *(u32x2*)(u + (size_t)row * 1024 + lane * 4 + 256 * i) = pk;
        }
      }
    }
  }
}

DI void act_phase(const Params& P, int l, int wid_s) {
  const bf16_t* __restrict__ vg = (const bf16_t*)(P.ws + OFF_AR); bf16_t* __restrict__ a = (bf16_t*)(P.ws + OFF_AR + 6 * SZ_U);
  const float* cw = P.ffn_cw + (size_t)l * 3 * 2816; const float* cb = P.ffn_cb + (size_t)l * 2816;
  const int tid = otid();
  for (int item = blockIdx.x; item < 272 * 352 / 256; item += gridDim.x) {
    const int u = item * 256 + tid; const int br = u / 352, ch = u - br * 352;
    const int r = (br >> 1) * 128 + (br & 1) * 127;
    const int p = r < TL ? (r & 4095) : ((r - TL) & 255); const int slen = r < TL ? 4096 : 256;
    const int f0 = ch * 8;
    const bf16_t* gp = vg + (size_t)r * 5632 + 2816 + f0;
    u32x4 g0 = {0, 0, 0, 0}, g2 = {0, 0, 0, 0};
    if (p != 0) g0 = *(const u32x4*)(gp - 5632);
    if (p + 1 < slen) g2 = *(const u32x4*)(gp + 5632);
    const u32x4 g1 = *(const u32x4*)gp, vv = *(const u32x4*)(vg + (size_t)r * 5632 + f0);
    float o[8];
#pragma unroll
    for (int qd = 0; qd < 4; ++qd) {
      const float x0 = cw[f0 + 2 * qd] * bflo(g0[qd]) + cw[2816 + f0 + 2 * qd] * bflo(g1[qd]) + cw[5632 + f0 + 2 * qd] * bflo(g2[qd]) + cb[f0 + 2 * qd];
      const float x1 = cw[f0 + 2 * qd + 1] * bfhi(g0[qd]) + cw[2816 + f0 + 2 * qd + 1] * bfhi(g1[qd]) + cw[5632 + f0 + 2 * qd + 1] * bfhi(g2[qd]) + cb[f0 + 2 * qd + 1];
      o[2 * qd] = siluf(x0) * bflo(vv[qd]); o[2 * qd + 1] = siluf(x1) * bfhi(vv[qd]);
    }
    u32x4 ov; ov.x = pk2(o[0], o[1]); ov.y = pk2(o[2], o[3]); ov.z = pk2(o[4], o[5]); ov.w = pk2(o[6], o[7]);
    *(u32x4*)(a + (size_t)r * 2816 + f0) = ov;
  }
}

DI void act_fix_tile(const Params& P, int l, int m0, int tid) {
  const bf16_t* vg = (const bf16_t*)(P.ws + OFF_AR); bf16_t* a = (bf16_t*)(P.ws + OFF_AR + 6 * SZ_U);
  const float* cw = P.ffn_cw + (size_t)l * 3 * 2816; const float* cb = P.ffn_cb + (size_t)l * 2816;
  for (int u = tid; u < 704; u += NTH) {
    const int br = u >= 352 ? 1 : 0, ch = u - br * 352;
    const int r = m0 + br * 127;
    const int p = r < TL ? (r & 4095) : ((r - TL) & 255); const int slen = r < TL ? 4096 : 256;
    const int f0 = ch * 8;
    const bf16_t* gp = vg + (size_t)r * 5632 + 2816 + f0;
    u32x4 g0 = {0, 0, 0, 0}, g2 = {0, 0, 0, 0};
    if (p != 0) g0 = *(const u32x4*)(gp - 5632);
    if (p + 1 < slen) g2 = *(const u32x4*)(gp + 5632);
    const u32x4 g1 = *(const u32x4*)gp, vv = *(const u32x4*)(vg + (size_t)r * 5632 + f0);
    float o[8];
#pragma unroll
    for (int qd = 0; qd < 4; ++qd) {
      const float x0 = cw[f0 + 2 * qd] * bflo(g0[qd]) + cw[2816 + f0 + 2 * qd] * bflo(g1[qd]) + cw[5632 + f0 + 2 * qd] * bflo(g2[qd]) + cb[f0 + 2 * qd];
      const float x1 = cw[f0 + 2 * qd + 1] * bfhi(g0[qd]) + cw[2816 + f0 + 2 * qd + 1] * bfhi(g1[qd]) + cw[5632 + f0 + 2 * qd + 1] * bfhi(g2[qd]) + cb[f0 + 2 * qd + 1];
      o[2 * qd] = siluf(x0) * bflo(vv[qd]); o[2 * qd + 1] = siluf(x1) * bfhi(vv[qd]);
    }
    u32x4 ov; ov.x = pk2(o[0], o[1]); ov.y = pk2(o[2], o[3]); ov.z = pk2(o[4], o[5]); ov.w = pk2(o[6], o[7]);
    *(u32x4*)(a + (size_t)r * 2816 + f0) = ov;
  }
  asm volatile("s_waitcnt vmcnt(0)" ::: "memory");
  __syncthreads();
}

enum { EPI_F32 = 0, EPI_BF16 = 1, EPI_ROPE_RET_N = 2, EPI_ROPE_RET_T = 3, EPI_ROPE_DIFF_N = 4, EPI_MERGE = 5, EPI_SMASK = 6, EPI_ACT = 7 };
struct Job { const bf16_t* A; const bf16_t* B; int lda, ldb, K, m0, n0, epi, ldc, aux, afrag; void* out; float scale; };

DI void gemm_tile(const Params& P, const Job& J, char* lds, int tid) {
  const int lane = tid & 63, w = tid >> 6, wm = w >> 1, wn = w & 1, l31 = lane & 31, hi = lane >> 5;
  f32x16 acc[2][2];
#pragma unroll
  for (int a = 0; a < 2; ++a)
#pragma unroll
    for (int b = 0; b < 2; ++b)
#pragma unroll
      for (int r = 0; r < 16; ++r) acc[a][b][r] = 0.f;
  const int lrow = tid >> 3, lkc = (tid & 7) ^ ((tid >> 4) & 7);
  const bf16_t* ga = J.afrag ? J.A + ((((size_t)(J.m0 >> 5) * 4 + (J.afrag - 1)) * 16 + (lkc >> 1)) * 64 + (lkc & 1) * 32 + lrow) * 8
                             : J.A + (size_t)(J.m0 + lrow) * J.lda + lkc * 8;
  const bf16_t* gb = J.B + (size_t)(J.n0 + lrow) * J.ldb + lkc * 8;
  const size_t sa = J.afrag ? (size_t)32768 : (size_t)32 * J.lda, sb = (size_t)32 * J.ldb;
  const size_t ksa = J.afrag ? 2048 : 64;
  const int swz = (lane >> 1) & 7;
  const int aoff = (64 * wm + l31) * 128, boff = 16384 + (64 * wn + l31) * 128;
  const int nk = J.K >> 6;
  char* wbase = lds + tid * 16;
#pragma unroll
  for (int i = 0; i < 4; ++i) { GLDS(ga + i * sa, wbase + i * 4096); GLDS(gb + i * sb, wbase + 16384 + i * 4096); }
  asm volatile("s_waitcnt vmcnt(0)" ::: "memory");
  __syncthreads();
  for (int kt = 0; kt < nk; ++kt) {
    const char* cur = lds + (kt & 1) * 32768; char* nxt = wbase + ((kt + 1) & 1) * 32768;
    if (kt + 1 < nk) {
#pragma unroll
      for (int i = 0; i < 4; ++i) { GLDS(ga + (size_t)(kt + 1) * ksa + i * sa, nxt + i * 4096); GLDS(gb + (size_t)(kt + 1) * 64 + i * sb, nxt + 16384 + i * 4096); }
    }
    bf16x8 fa[2][2], fb[2][2];
    { const int ko = ((0 + hi) ^ swz) << 4;
      fa[0][0] = *(const bf16x8*)(cur + aoff + ko); fa[0][1] = *(const bf16x8*)(cur + aoff + 4096 + ko);
      fb[0][0] = *(const bf16x8*)(cur + boff + ko); fb[0][1] = *(const bf16x8*)(cur + boff + 4096 + ko); }
#pragma unroll
    for (int s = 0; s < 4; ++s) {
      const int c = s & 1, n = c ^ 1;
      if (s < 3) {
        const int ko = ((2 * (s + 1) + hi) ^ swz) << 4;
        fa[n][0] = *(const bf16x8*)(cur + aoff + ko); fa[n][1] = *(const bf16x8*)(cur + aoff + 4096 + ko);
        fb[n][0] = *(const bf16x8*)(cur + boff + ko); fb[n][1] = *(const bf16x8*)(cur + boff + 4096 + ko);
      }
      acc[0][0] = MFMA(fa[c][0], fb[c][0], acc[0][0]); acc[0][1] = MFMA(fa[c][0], fb[c][1], acc[0][1]);
      acc[1][0] = MFMA(fa[c][1], fb[c][0], acc[1][0]); acc[1][1] = MFMA(fa[c][1], fb[c][1], acc[1][1]);
      __builtin_amdgcn_sched_barrier(0);
    }
    asm volatile("s_waitcnt vmcnt(0)" ::: "memory");
    __syncthreads();
  }
  int l31e = l31, hie = hi; asm volatile("" : "+v"(l31e), "+v"(hie));
  const int m0w = J.m0 + 64 * wm, n0w = J.n0 + 64 * wn;
  if (J.epi == EPI_F32) {
    float* o = (float*)J.out;
#pragma unroll
    for (int tm = 0; tm < 2; ++tm)
#pragma unroll
      for (int tn = 0; tn < 2; ++tn)
#pragma unroll
        for (int r = 0; r < 16; ++r) o[(size_t)(m0w + 32 * tm + crow(r, hie)) * J.ldc + n0w + 32 * tn + l31e] = acc[tm][tn][r];
    return;
  }
  constexpr int IST = 272;
  char* img = lds;
  bf16_t* obase; size_t oldc; int ocols = 128, ist = IST;
  if (J.epi == EPI_BF16) {
#pragma unroll
    for (int tm = 0; tm < 2; ++tm)
#pragma unroll
      for (int tn = 0; tn < 2; ++tn)
#pragma unroll
        for (int r = 0; r < 16; ++r) {
          int cl = 64 * wn + 32 * tn + l31e;
          if (J.aux & 1) cl = (cl & ~12) | ((cl & 4) << 1) | ((cl & 8) >> 1);
          *(bf16_t*)(img + (64 * wm + 32 * tm + crow(r, hie)) * IST + cl * 2) = f2bf(acc[tm][tn][r]);
        }
    obase = (bf16_t*)J.out + (size_t)J.m0 * J.ldc + J.n0; oldc = J.ldc;
  } else if (J.epi == EPI_ROPE_RET_N) {
    const int g128 = n0w >> 7, fi = 32 * wn + l31e;
#pragma unroll
    for (int tm = 0; tm < 2; ++tm)
#pragma unroll
      for (int r = 0; r < 16; ++r) {
        const int rl = 64 * wm + 32 * tm + crow(r, hie), row = J.m0 + rl;
        float x1 = acc[tm][0][r], x2 = acc[tm][1][r];
        if (row < TL) { const int pos = (g128 & 1) ? (row & 63) : ((row >> 6) & 63); const f32x2 cs = rope_cs(pos, fi, 13.287712379549449f / 64.f); const float y1 = x1 * cs.x - x2 * cs.y, y2 = x1 * cs.y + x2 * cs.x; x1 = y1; x2 = y2; }
        *(bf16_t*)(img + rl * IST + fi * 2) = f2bf(x1 * J.scale); *(bf16_t*)(img + rl * IST + (fi + 64) * 2) = f2bf(x2 * J.scale);
      }
    obase = (bf16_t*)J.out + (size_t)J.m0 * 1024 + J.n0; oldc = 1024;
  } else if (J.epi == EPI_ROPE_RET_T) {
    const int g128 = m0w >> 7;
#pragma unroll
    for (int tn = 0; tn < 2; ++tn) {
      const int cl = 64 * wn + 32 * tn + l31e, tok = J.n0 + cl; const int pos = (g128 & 1) ? (tok & 63) : ((tok >> 6) & 63);
#pragma unroll
      for (int r = 0; r < 16; ++r) {
        const int fi = 32 * wm + crow(r, hie);
        float x1 = acc[0][tn][r], x2 = acc[1][tn][r];
        if (tok < TL) { const f32x2 cs = rope_cs(pos, fi, 13.287712379549449f / 64.f); const float y1 = x1 * cs.x - x2 * cs.y, y2 = x1 * cs.y + x2 * cs.x; x1 = y1; x2 = y2; }
        *(bf16_t*)(img + fi * IST + cl * 2) = f2bf(x1 * J.scale); *(bf16_t*)(img + (fi + 64) * IST + cl * 2) = f2bf(x2 * J.scale);
      }
    }
    obase = (bf16_t*)J.out + (size_t)J.m0 * T + J.n0; oldc = T;
  } else if (J.epi == EPI_ROPE_DIFF_N) {
    const int fi = l31e & 15, c1 = 64 * wn + (l31e < 16 ? l31e : l31e + 16);
#pragma unroll
    for (int tm = 0; tm < 2; ++tm)
#pragma unroll
      for (int r = 0; r < 16; ++r) {
        const int rl = 64 * wm + 32 * tm + crow(r, hie), row = J.m0 + rl;
        float x1 = acc[tm][0][r], x2 = acc[tm][1][r];
        if (row < TL) { const int pos = (l31e < 16) ? ((row >> 6) & 63) : (row & 63); const f32x2 cs = rope_cs(pos, fi, 13.287712379549449f / 16.f); const float y1 = x1 * cs.x - x2 * cs.y, y2 = x1 * cs.y + x2 * cs.x; x1 = y1; x2 = y2; }
        *(bf16_t*)(img + rl * IST + c1 * 2) = f2bf(x1); *(bf16_t*)(img + rl * IST + (c1 + 16) * 2) = f2bf(x2);
      }
    obase = (bf16_t*)J.out + (size_t)J.m0 * 1024 + J.n0; oldc = 1024;
  } else if (J.epi == EPI_SMASK) {
    const int il4 = J.aux, hh = il4 & 3;
    const float lgf = -log2f(1.f + expf(-P.ret_df[il4])), lgb = -log2f(1.f + expf(-P.ret_db[il4]));
#pragma unroll
    for (int d = 0; d < 2; ++d) {
#pragma unroll
      for (int tm = 0; tm < 2; ++tm)
#pragma unroll
        for (int tn = 0; tn < 2; ++tn)
#pragma unroll
          for (int r = 0; r < 16; ++r) {
            const int i = 64 * wm + 32 * tm + crow(r, hie), j = 64 * wn + 32 * tn + l31e, dd = d ? j - i : i - j;
            const float v = dd >= 0 ? acc[tm][tn][r] * ex2((d ? lgb : lgf) * (float)dd) : 0.f;
            *(bf16_t*)(img + i * IST + j * 2) = f2bf(v);
          }
      __syncthreads();
      bf16_t* ob2 = (bf16_t*)J.out + (size_t)J.m0 * 1024 + hh * 256 + d * 128;
#pragma unroll
      for (int i = 0; i < 8; ++i) { const int c = tid + 256 * i, row = c >> 4, cc = c & 15, hb = ((d * 4 + (row >> 5)) * 8 + (cc >> 1)) * 2 + (cc & 1);
        *(u32x4*)((bf16_t*)J.out + (size_t)(J.m0 + hb) * 1024 + hh * 256 + (row & 31) * 8) = *(const u32x4*)(img + row * IST + cc * 16); }
      __syncthreads();
    }
    return;
  } else if (J.epi == EPI_ACT) {
#pragma unroll
    for (int tm = 0; tm < 2; ++tm)
#pragma unroll
      for (int tn = 0; tn < 2; ++tn)
#pragma unroll
        for (int r = 0; r < 16; ++r) *(bf16_t*)(img + (64 * wm + 32 * tm + crow(r, hie)) * IST + (64 * wn + 32 * tn + l31e) * 2) = f2bf(acc[tm][tn][r]);
    __syncthreads();
    {
      const int ch = tid & 7, rg = tid >> 3, f0 = 64 * (J.n0 >> 7) + 8 * ch;
      const float* cw = P.ffn_cw + (size_t)J.aux * 3 * 2816; const float* cb = P.ffn_cb + (size_t)J.aux * 2816;
      float w0[8], w1[8], w2[8], bb[8];
#pragma unroll
      for (int j = 0; j < 8; ++j) { w0[j] = cw[f0 + j]; w1[j] = cw[2816 + f0 + j]; w2[j] = cw[5632 + f0 + j]; bb[j] = cb[f0 + j]; }
      const int slen = J.m0 < TL ? 4096 : 256, p0 = J.m0 < TL ? (J.m0 & 4095) : ((J.m0 - TL) & 255);
      const bool sstart = p0 == 0, send = p0 + 128 == slen;
      u32x4 g[6], vv[4];
#pragma unroll
      for (int qd = 0; qd < 6; ++qd) { const int lr = 4 * rg - 1 + qd; g[qd] = (u32x4){0, 0, 0, 0}; if (lr >= 0 && lr < 128) g[qd] = *(const u32x4*)(img + lr * IST + (64 + 8 * ch) * 2); }
#pragma unroll
      for (int qd = 0; qd < 4; ++qd) vv[qd] = *(const u32x4*)(img + (4 * rg + qd) * IST + 8 * ch * 2);
      bf16_t* aout = (bf16_t*)J.out; bf16_t* vgb = (bf16_t*)(P.ws + OFF_AR);
#pragma unroll
      for (int qd = 0; qd < 4; ++qd) {
        const int lr = 4 * rg + qd;
        float o[8];
#pragma unroll
        for (int k2 = 0; k2 < 4; ++k2) {
          const float x0 = w0[2 * k2] * bflo(g[qd][k2]) + w1[2 * k2] * bflo(g[qd + 1][k2]) + w2[2 * k2] * bflo(g[qd + 2][k2]) + bb[2 * k2];
          const float x1 = w0[2 * k2 + 1] * bfhi(g[qd][k2]) + w1[2 * k2 + 1] * bfhi(g[qd + 1][k2]) + w2[2 * k2 + 1] * bfhi(g[qd + 2][k2]) + bb[2 * k2 + 1];
          o[2 * k2] = siluf(x0) * bflo(vv[qd][k2]); o[2 * k2 + 1] = siluf(x1) * bfhi(vv[qd][k2]);
        }
        if ((lr > 0 || sstart) && (lr < 127 || send)) {
          u32x4 ov; ov.x = pk2(o[0], o[1]); ov.y = pk2(o[2], o[3]); ov.z = pk2(o[4], o[5]); ov.w = pk2(o[6], o[7]);
          *(u32x4*)(aout + (size_t)(J.m0 + lr) * 2816 + f0) = ov;
        }
        if (lr < 2 || lr > 125) {
          *(u32x4*)(vgb + (size_t)(J.m0 + lr) * 5632 + f0) = vv[qd];
          *(u32x4*)(vgb + (size_t)(J.m0 + lr) * 5632 + 2816 + f0) = g[qd + 1];
        }
      }
    }
    __syncthreads();
    return;
  } else {
    constexpr int MST = 144;
    char* oft = lds + 18432; char* obt = lds + 36864; float* rs = (float*)(lds + 55296);
    const int f0 = J.n0 >> 1, hd = f0 >> 9;
    const bf16_t* of = (const bf16_t*)(P.ws + OFF_AR + 5 * SZ_U); const bf16_t* ob = (const bf16_t*)(P.ws + OFF_AR + 7 * SZ_U);
    {
      const int row = tid & 127, dir = tid >> 7;
      const float* sp = (const float*)(P.ws + OFF_SSQ) + (dir ? (size_t)T * 64 : 0) + ((size_t)(J.m0 + row) * 4 + hd) * 16;
      float sm = 0.f;
#pragma unroll
      for (int qd = 0; qd < 4; ++qd) { const f32x4 pv = *(const f32x4*)(sp + 4 * qd); sm += (pv.x + pv.y) + (pv.z + pv.w); }
      rs[tid] = rsqrtf(sm * (1.f / 512.f) + EPS);
#pragma unroll
      for (int i = 0; i < 4; ++i) {
        const int c = tid + 256 * i, r2 = c >> 3, cc = c & 7;
        *(u32x4*)(oft + r2 * MST + cc * 16) = *(const u32x4*)(of + (size_t)(J.m0 + r2) * 2048 + f0 + cc * 8);
        *(u32x4*)(obt + r2 * MST + cc * 16) = *(const u32x4*)(ob + (size_t)(J.m0 + r2) * 2048 + f0 + cc * 8);
      }
    }
    __syncthreads();
    const int cl = 32 * wn + l31e;
#pragma unroll
    for (int tm = 0; tm < 2; ++tm)
#pragma unroll
      for (int r = 0; r < 16; ++r) {
        const int rl = 64 * wm + 32 * tm + crow(r, hie);
        const float vf = bf2f(*(const bf16_t*)(oft + rl * MST + cl * 2)) * rs[rl], vb = bf2f(*(const bf16_t*)(obt + rl * MST + cl * 2)) * rs[128 + rl];
        *(bf16_t*)(img + rl * MST + cl * 2) = f2bf(siluf(acc[tm][0][r]) * vf + siluf(acc[tm][1][r]) * vb);
      }
    obase = (bf16_t*)J.out + (size_t)J.m0 * 2048 + f0; oldc = 2048; ocols = 64; ist = MST;
  }
  __syncthreads();
  if (ocols == 128 && (J.aux & 2)) {
    const int ci = J.n0 >> 7;
#pragma unroll
    for (int i = 0; i < 8; ++i) {
      const int c = tid + 256 * i, row = c >> 4, cc = c & 15, gt = (J.m0 + row) >> 5;
      bf16_t* dst = (bf16_t*)J.out + ((((size_t)gt * 136 + ci) * 8 + (cc >> 1)) * 64 + (cc & 1) * 32 + (row & 31)) * 8;
      *(u32x4*)dst = *(const u32x4*)(img + row * ist + cc * 16);
    }
  } else if (ocols == 128 && (J.aux & 8)) {
    const int hq = J.n0 >> 8, s0 = ((J.n0 >> 7) & 1) * 8;
#pragma unroll
    for (int i = 0; i < 8; ++i) {
      const int c = tid + 256 * i, row = c >> 4, cc = c & 15, rt = (J.m0 + row) >> 5;
      bf16_t* dst = (bf16_t*)J.out + ((((size_t)rt * 4 + hq) * 16 + s0 + (cc >> 1)) * 64 + (cc & 1) * 32 + (row & 31)) * 8;
      *(u32x4*)dst = *(const u32x4*)(img + row * ist + cc * 16);
    }
  } else if (ocols == 128) {
#pragma unroll
    for (int i = 0; i < 8; ++i) { const int c = tid + 256 * i, row = c >> 4, cc = c & 15; *(u32x4*)(obase + (size_t)row * oldc + cc * 8) = *(const u32x4*)(img + row * ist + cc * 16); }
  } else {
#pragma unroll
    for (int i = 0; i < 4; ++i) { const int c = tid + 256 * i, row = c >> 3, cc = c & 7; *(u32x4*)(obase + (size_t)row * oldc + cc * 8) = *(const u32x4*)(img + row * ist + cc * 16); }
  }
  __syncthreads();
}

DI void tile_mn(int idx, int nN, int& tm, int& tn) { const int per = 8 * nN, mg = idx / per, rem = idx % per; tn = rem >> 3; tm = mg * 8 + (rem & 7); }

enum { GP_RET_IN = 0, GP_RET_GATE, GP_RET_OUT, GP_DIFF_IN, GP_DIFF_OUT, GP_FFN_UP, GP_FFN_DOWN, GP_RET_S };
DI void gemm_phase(const Params& P, int kind, char* lds, int layer, int wid_s) {
  const bf16_t* U = (const bf16_t*)(P.ws + OFF_U); const bf16_t* WM = (const bf16_t*)(P.ws + OFF_WM); const bf16_t* WF = (const bf16_t*)(P.ws + OFF_WF);
  char* AR = P.ws + OFF_AR;
  int total;
  switch (kind) {
    case GP_RET_IN: total = 1088 * 5; break;
    case GP_RET_S: total = 544; break;
    case GP_RET_GATE: total = 136 * 32; break;
    case GP_DIFF_IN: total = 1088 * 3; break;
    case GP_FFN_UP: total = 136 * 44; break;
    default: total = 1024 + 256; break;
  }
  const int G = gridDim.x, per = G >> 3; const int tid = otid();
  for (int base = 0; base < total; base += G) {
    int L = base + ((G & 7) == 0 ? (int)(blockIdx.x & 7) * per + (int)(blockIdx.x >> 3) : (int)blockIdx.x);
    if (L >= total) continue;
    Job J; J.lda = 1024; J.ldb = 1024; J.K = 1024; J.scale = 1.f; J.ldc = 1024; J.aux = 0; J.afrag = 0;
    int tm, tn;
    if (kind == GP_RET_S) { const int hh = L & 3, ci = L >> 2; tm = ci; tn = ci; J.A = (const bf16_t*)AR; J.afrag = 1 + hh; J.B = (const bf16_t*)(AR + SZ_U) + hh * 256; J.K = 256; J.epi = EPI_SMASK; J.out = AR + SZ_U; J.aux = (layer >> 1) * 4 + hh; }
    else if (kind == GP_RET_IN) {
      if (L < 1088) { tile_mn(L, 8, tm, tn); J.A = U; J.B = WM; J.epi = EPI_ROPE_RET_N; J.out = AR; J.aux = 8; }
      else if (L < 2176) { tile_mn(L - 1088, 8, tm, tn); J.A = U; J.B = WM + (size_t)1024 * 1024; J.epi = EPI_ROPE_RET_N; J.out = AR + SZ_U; J.scale = 0.0625f; }
      else if (L < 3264) { tile_mn(L - 2176, 136, tm, tn); J.A = WM + (size_t)1024 * 1024; J.B = U; J.epi = EPI_ROPE_RET_T; J.out = AR + 2 * SZ_U; J.scale = 0.0625f; J.aux = 2; }
      else { tile_mn(L - 3264, 136, tm, tn); J.A = WM + (size_t)2048 * 1024; J.B = U; J.epi = EPI_BF16; J.out = AR + 3 * SZ_U; J.ldc = T; J.aux = 2; }
    } else if (kind == GP_RET_GATE) { tile_mn(L, 32, tm, tn); J.A = U; J.B = WM + (size_t)4096 * 1024; J.epi = EPI_MERGE; J.out = AR; }
    else if (kind == GP_RET_OUT) { tile_mn(L < 1024 ? L : 1024 + ((L - 1024) >> 2), 8, tm, tn); J.A = (const bf16_t*)AR; J.lda = 2048; J.B = WM + (size_t)8192 * 1024; J.ldb = 2048; J.K = 2048; J.epi = EPI_BF16; J.out = AR + 3 * SZ_U; }
    else if (kind == GP_DIFF_IN) {
      if (L < 1088) { tile_mn(L, 8, tm, tn); J.A = U; J.B = WM; J.epi = EPI_ROPE_DIFF_N; J.out = AR; }
      else if (L < 2176) { tile_mn(L - 1088, 8, tm, tn); J.A = U; J.B = WM + (size_t)1024 * 1024; J.epi = EPI_ROPE_DIFF_N; J.out = AR + SZ_U; }
      else { tile_mn(L - 2176, 136, tm, tn); J.A = WM + (size_t)2048 * 1024; J.B = U; J.epi = EPI_BF16; J.out = AR + 2 * SZ_U; J.ldc = T; J.aux = 1; }
    } else if (kind == GP_DIFF_OUT) { tile_mn(L < 1024 ? L : 1024 + ((L - 1024) >> 2), 8, tm, tn); J.A = (const bf16_t*)(AR + 5 * SZ_U); J.B = WM + (size_t)3072 * 1024; J.epi = EPI_BF16; J.out = AR + 3 * SZ_U; }
    else if (kind == GP_FFN_UP) { tile_mn(L, 44, tm, tn); J.A = U; J.B = WF; J.epi = EPI_ACT; J.out = AR + 6 * SZ_U; J.aux = layer; }
    else { tile_mn(L < 1024 ? L : 1024 + ((L - 1024) >> 2), 8, tm, tn); J.A = (const bf16_t*)(AR + 6 * SZ_U); J.lda = 2816; J.B = WF + (size_t)5632 * 1024; J.ldb = 2816; J.K = 2816; J.epi = EPI_BF16; J.out = AR; }
    if ((kind == GP_RET_OUT || kind == GP_DIFF_OUT || kind == GP_FFN_DOWN) && L >= 1024) {
      const int kp = (L - 1024) & 3, kq = J.K >> 2;
      J.A += kp * kq; J.B += kp * kq; J.K = kq; J.epi = EPI_F32; J.ldc = 1024;
      J.out = (float*)(AR + 4 * SZ_U) + (size_t)kp * 1024 * 1024 - (size_t)TL * 1024;
    }
    J.m0 = tm * 128; J.n0 = tn * 128;
    if (kind == GP_FFN_DOWN) act_fix_tile(P, layer, J.m0, tid);
    gemm_tile(P, J, lds, tid);
  }
}

DI void write_rt(const f32x16 (&accR)[2], char* lds, int w, int l31, int hi) {
#pragma unroll
  for (int td = 0; td < 2; ++td)
#pragma unroll
    for (int g = 0; g < 4; ++g) {
      const int d = 64 * w + 32 * td + 8 * g + 4 * hi, v = l31;
      u32x2 pk; pk.x = pk2(accR[td][4 * g], accR[td][4 * g + 1]); pk.y = pk2(accR[td][4 * g + 2], accR[td][4 * g + 3]);
      *(u32x2*)(lds + v * 512 + (((d >> 3) ^ (v & 15)) << 4) + (d & 7) * 2) = pk;
    }
}
DI int ret_r0(int cc, int dir, int b) { return cc < 2 ? TL + b * 256 + 128 * (dir ? 1 - cc : cc) : b * 4096 + 128 * (dir ? 33 - cc : cc - 2); }
DI void ret_phase(const Params& P, int l, char* lds, int wid_s) {
  const int tid = otid(), lane = tid & 63, w = tid >> 6, l31 = lane & 31, hi = lane >> 5, il = l >> 1;
  const char* q = P.ws + OFF_AR; const char* pd = P.ws + OFF_AR + SZ_U;
  const char* kT = P.ws + OFF_AR + 2 * SZ_U; const char* vT = P.ws + OFF_AR + 3 * SZ_U;
  for (int item = blockIdx.x; item < 512; item += gridDim.x) {
    const int dvs = item & 15, dir = (item >> 4) & 1, hh = (item >> 5) & 3, b = item >> 7;
    const float logit = (dir ? P.ret_db : P.ret_df)[il * 4 + hh];
    const float l2g = -log2f(1.f + expf(-logit));
    const float cdec = ex2(l2g * 128.f);
    const float gstep = ex2(dir ? l2g : -l2g);
    char* obuf = P.ws + OFF_AR + (dir ? 7 : 5) * SZ_U;
    float* ssq = (float*)(P.ws + OFF_SSQ) + (dir ? (size_t)T * 64 : 0);
    f32x16 accR[2];
#pragma unroll
    for (int a = 0; a < 2; ++a)
#pragma unroll
      for (int r = 0; r < 16; ++r) accR[a][r] = 0.f;
    __syncthreads();
    write_rt(accR, lds, w, l31, hi);
    __syncthreads();
    bf16x8 pa[8], bv[8], bq[16];
    {
      const int r0 = ret_r0(0, dir, b);
      const unsigned po = (unsigned)((((((r0 >> 5) + w) * 4 + hh) * 16) * 64) + lane) * 16u;
      const unsigned pf = (unsigned)((r0 + (dir * 4 + w) * 16 + hi) * 1024 + hh * 256 + l31 * 8) * 2u;
      const unsigned vo = (unsigned)((((hh * 16 + dvs) * 136 + (r0 >> 7)) * 8) * 64 + lane) * 16u;
#pragma unroll
      for (int s = 0; s < 8; ++s) { pa[s] = *(const bf16x8*)(pd + (pf + 4096u * s)); bv[s] = *(const bf16x8*)(vT + (vo + 1024u * s)); }
#pragma unroll
      for (int s = 0; s < 16; ++s) bq[s] = *(const bf16x8*)(q + (po + 1024u * s));
    }
    for (int cc = 0; cc < 34; ++cc) {
      float lg = l2g; int hiv = hi, l31v = l31; asm volatile("" : "+v"(lg), "+v"(hiv), "+v"(l31v));
      const int r0 = ret_r0(cc, dir, b);
      f32x16 accO, accQ;
#pragma unroll
      for (int r = 0; r < 16; ++r) { accO[r] = 0.f; accQ[r] = 0.f; }
#pragma unroll
      for (int s = 0; s < 8; ++s) accO = MFMA(pa[s], bv[s], accO);
#pragma unroll
      for (int s = 0; s < 16; ++s) { const bf16x8 br = *(const bf16x8*)(lds + l31v * 512 + (((2 * s + hiv) ^ (l31v & 15)) << 4)); accQ = MFMA(bq[s], br, accQ); }
#pragma unroll
      for (int r = 0; r < 16; ++r) {
        const int i2 = 32 * w + crow(r, hiv); const float e = dir ? (float)(128 - i2) : (float)(i2 + 1);
        const float o = accO[r] + ex2(lg * e) * accQ[r];
        const int row = r0 + i2;
        *(bf16_t*)(obuf + (unsigned)(row * 2048 + hh * 512 + dvs * 32 + l31v) * 2u) = f2bf(o);
        float sq = o * o;
        sq = dpp_xadd<0xB1>(sq); sq = dpp_xadd<0x4E>(sq); sq = dpp_xadd<0x141>(sq); sq = dpp_xadd<0x140>(sq);
        sq += __shfl_xor(sq, 16);
        if (l31v == 0) ssq[(row * 4 + hh) * 16 + dvs] = sq;
      }
      __builtin_amdgcn_sched_barrier(0);
      bf16x8 ak[2][8];
      if (cc < 33) {
        const unsigned kto = (unsigned)((((hh * 8 + 2 * w) * 136 + (r0 >> 7)) * 8) * 64 + l31v + 32 * hiv) * 16u;
#pragma unroll
        for (int td = 0; td < 2; ++td)
#pragma unroll
          for (int s = 0; s < 8; ++s) ak[td][s] = *(const bf16x8*)(kT + (kto + (unsigned)(td * 136 * 8 * 64 * 16) + 1024u * s));
      }
      if (cc < 33) {
#pragma unroll
        for (int a = 0; a < 2; ++a)
#pragma unroll
          for (int r = 0; r < 16; ++r) accR[a][r] *= cdec;
#pragma unroll
        for (int s = 0; s < 8; ++s) {
          float z[8];
          { const int j0 = 16 * s + 8 * hiv; z[0] = ex2(lg * (float)(dir ? j0 : 127 - j0));
#pragma unroll
            for (int e = 1; e < 8; ++e) z[e] = z[e - 1] * gstep; }
          const u32x4 raw = __builtin_bit_cast(u32x4, bv[s]);
          u32x4 sc;
          sc.x = pk2(bflo(raw.x) * z[0], bfhi(raw.x) * z[1]); sc.y = pk2(bflo(raw.y) * z[2], bfhi(raw.y) * z[3]);
          sc.z = pk2(bflo(raw.z) * z[4], bfhi(raw.z) * z[5]); sc.w = pk2(bflo(raw.w) * z[6], bfhi(raw.w) * z[7]);
          const bf16x8 bvs = __builtin_bit_cast(bf16x8, sc);
          accR[0] = MFMA(ak[0][s], bvs, accR[0]); accR[1] = MFMA(ak[1][s], bvs, accR[1]);
        }
        const int r1 = ret_r0(cc + 1, dir, b);
        const unsigned po = (unsigned)((((((r1 >> 5) + w) * 4 + hh) * 16) * 64) + l31v + 32 * hiv) * 16u;
        const unsigned pf = (unsigned)((r1 + (dir * 4 + w) * 16 + hiv) * 1024 + hh * 256 + l31v * 8) * 2u;
        const unsigned vo = (unsigned)((((hh * 16 + dvs) * 136 + (r1 >> 7)) * 8) * 64 + l31v + 32 * hiv) * 16u;
#pragma unroll
        for (int s = 0; s < 8; ++s) { pa[s] = *(const bf16x8*)(pd + (pf + 4096u * s)); bv[s] = *(const bf16x8*)(vT + (vo + 1024u * s)); }
#pragma unroll
        for (int s = 0; s < 16; ++s) bq[s] = *(const bf16x8*)(q + (po + 1024u * s));
        __builtin_amdgcn_sched_barrier(0);
        __syncthreads();
        write_rt(accR, lds, w, l31v, hiv);
        __syncthreads();
      }
    }
  }
}

DI void att_phase(const Params& P, int l, char* lds, int wid_s) {
  const int tid = otid(), lane = tid & 63, w = tid >> 6, l31 = lane & 31, hi = lane >> 5, il = l >> 1;
  const bf16_t* q = (const bf16_t*)(P.ws + OFF_AR); const bf16_t* k = (const bf16_t*)(P.ws + OFF_AR + SZ_U);
  const bf16_t* vT = (const bf16_t*)(P.ws + OFF_AR + 2 * SZ_U); bf16_t* att = (bf16_t*)(P.ws + OFF_AR + 5 * SZ_U);
  const float csc = 0.125f * 1.4426950408889634f;
  for (int item = blockIdx.x; item < 1024 + 64; item += gridDim.x) {
    int b, hh, R0, nt, nlat;
    if (item < 1024) { b = item >> 8; hh = (item >> 5) & 7; R0 = b * 4096 + 128 * (item & 31); nt = 68; nlat = 64; }
    else { const int i2 = item - 1024; b = i2 >> 4; hh = (i2 >> 1) & 7; R0 = TL + b * 256 + 128 * (i2 & 1); nt = 4; nlat = 0; }
    const int qrow = R0 + 32 * w + l31;
    bf16x8 bq[2][4];
#pragma unroll
    for (int r2 = 0; r2 < 2; ++r2)
#pragma unroll
      for (int s = 0; s < 4; ++s) bq[r2][s] = *(const bf16x8*)(q + (size_t)qrow * 1024 + hh * 128 + 64 * r2 + 16 * s + 8 * hi);
    f32x16 oT[2][4];
#pragma unroll
    for (int r2 = 0; r2 < 2; ++r2)
#pragma unroll
      for (int a = 0; a < 4; ++a)
#pragma unroll
        for (int r = 0; r < 16; ++r) oT[r2][a][r] = 0.f;
    float mrun[2] = {-1e30f, -1e30f}, lsum[2] = {0.f, 0.f};
    auto keybase = [&](int t) { return t < nlat ? b * 4096 + 64 * t : TL + b * 256 + 64 * (t - nlat); };
    auto dma = [&](int t, int buf) {
      int t2 = tid; asm volatile("" : "+v"(t2));
      const int kch = (t2 & 15) ^ ((t2 >> 4) & 15), krow_l = t2 >> 4;
      const int vch = (t2 & 7) ^ ((t2 >> 4) & 7), vrow_l = t2 >> 3;
      const int kb = keybase(t);
      const unsigned ko = (unsigned)((kb + krow_l) * 1024 + hh * 128 + kch * 8) * 2u;
      const unsigned vo = (unsigned)((hh * 128 + vrow_l) * T + kb + vch * 8) * 2u;
      char* kd = lds + buf * 16384 + t2 * 16; char* vd = lds + 32768 + buf * 16384 + t2 * 16;
#pragma unroll
      for (int i = 0; i < 4; ++i) {
        GLDS((const char*)k + (ko + (unsigned)(i * 16 * 1024 * 2)), kd + i * 4096);
        GLDS((const char*)vT + (vo + (unsigned)(i * 32 * T * 2)), vd + i * 4096);
      }
    };
    __syncthreads();
    dma(0, 0);
    asm volatile("s_waitcnt vmcnt(0)" ::: "memory");
    __syncthreads();
    for (int t = 0; t < nt; ++t) {
      const char* kb_ = lds + (t & 1) * 16384; const char* vb_ = lds + 32768 + (t & 1) * 16384;
      if (t + 1 < nt) dma(t + 1, (t + 1) & 1);
#pragma unroll
      for (int r2 = 0; r2 < 2; ++r2) {
        int l31v = l31, hiv = hi; asm volatile("" : "+v"(l31v), "+v"(hiv));
        f32x16 st[2];
#pragma unroll
        for (int jt = 0; jt < 2; ++jt) {
#pragma unroll
          for (int r = 0; r < 16; ++r) st[jt][r] = 0.f;
          const int row = 32 * jt + l31v;
#pragma unroll
          for (int s = 0; s < 4; ++s) { const bf16x8 ak = *(const bf16x8*)(kb_ + row * 256 + (((8 * r2 + 2 * s + hiv) ^ (row & 15)) << 4)); st[jt] = MFMA(ak, bq[r2][s], st[jt]); }
        }
        float mx = st[0][0];
#pragma unroll
        for (int r = 1; r < 16; ++r) mx = fmaxf(mx, st[0][r]);
#pragma unroll
        for (int r = 0; r < 16; ++r) mx = fmaxf(mx, st[1][r]);
        mx = fmaxf(mx, __shfl_xor(mx, 32));
        const float mnew = fmaxf(mrun[r2], mx * csc), alpha = ex2(mrun[r2] - mnew);
        mrun[r2] = mnew;
        float ps = 0.f;
#pragma unroll
        for (int jt = 0; jt < 2; ++jt)
#pragma unroll
          for (int r = 0; r < 16; ++r) { const float p = ex2(st[jt][r] * csc - mnew); st[jt][r] = p; ps += p; }
        lsum[r2] = lsum[r2] * alpha + ps;
#pragma unroll
        for (int a = 0; a < 4; ++a)
#pragma unroll
          for (int r = 0; r < 16; ++r) oT[r2][a][r] *= alpha;
#pragma unroll
        for (int jt = 0; jt < 2; ++jt)
#pragma unroll
          for (int s2 = 0; s2 < 2; ++s2) {
            const bf16x8 pb = pack8(st[jt], s2);
            const int chunk = 4 * jt + 2 * s2 + hiv;
#pragma unroll
            for (int tv = 0; tv < 4; ++tv) {
              const int v = 32 * tv + l31v, sw = (v >> 1) & 7;
              const bf16x8 av = *(const bf16x8*)(vb_ + v * 128 + ((chunk ^ sw) << 4));
              oT[r2][tv] = MFMA(av, pb, oT[r2][tv]);
              if (tv & 1) __builtin_amdgcn_sched_barrier(0);
            }
          }
      }
      asm volatile("s_waitcnt vmcnt(0)" ::: "memory");
      __syncthreads();
    }
    lsum[0] += __shfl_xor(lsum[0], 32); lsum[1] += __shfl_xor(lsum[1], 32);
    int lv = l; asm volatile("" : "+s"(lv));
    const float lam_init = (lv == 1) ? 0.3555090676f : 0.5560582042f;
    float d1 = 0.f, d2 = 0.f;
    for (int e = 0; e < 64; ++e) { d1 += P.lq1[il * 64 + e] * P.lk1[il * 64 + e]; d2 += P.lq2[il * 64 + e] * P.lk2[il * 64 + e]; }
    const float lam = ex2(d1 * 1.4426950408889634f) - ex2(d2 * 1.4426950408889634f) + lam_init;
    const float inv0 = __builtin_amdgcn_rcpf(lsum[0]), inv1 = lam * __builtin_amdgcn_rcpf(lsum[1]);
    float ss = 0.f;
#pragma unroll
    for (int a = 0; a < 4; ++a)
#pragma unroll
      for (int r = 0; r < 16; ++r) { const float o = oT[0][a][r] * inv0 - oT[1][a][r] * inv1; oT[0][a][r] = o; ss += o * o; }
    ss += __shfl_xor(ss, 32);
    const float rstd = __builtin_amdgcn_rsqf(ss * (1.f / 128.f) + EPS) * (1.f - lam_init);
    const float* sg = P.subln + il * 128;
    int t3 = tid; asm volatile("" : "+v"(t3));
    const int qrow2 = R0 + 32 * (t3 >> 6) + (t3 & 31), hi3 = (t3 >> 5) & 1;
#pragma unroll
    for (int a = 0; a < 4; ++a)
#pragma unroll
      for (int g = 0; g < 4; ++g) {
        const int v = 32 * a + 8 * g + 4 * hi3;
        const f32x4 gg = *(const f32x4*)(sg + v);
        u32x2 pk; pk.x = pk2(oT[0][a][4 * g] * rstd * gg.x, oT[0][a][4 * g + 1] * rstd * gg.y); pk.y = pk2(oT[0][a][4 * g + 2] * rstd * gg.z, oT[0][a][4 * g + 3] * rstd * gg.w);
        *(u32x2*)(att + (size_t)qrow2 * 1024 + hh * 128 + v) = pk;
      }
  }
}

__global__ void __launch_bounds__(NTH, 2) fwd_kernel(Params P) {
  __shared__ __attribute__((aligned(16))) char lds[65536];
  cg::grid_group grid = cg::this_grid();
  int ph = 0;
  __shared__ unsigned xb_st[4];
  const int wid_s = __builtin_amdgcn_readfirstlane((int)threadIdx.x >> 6);
  if (wid_s == 0 && lane_id() < 4) xb_st[lane_id()] = 0u;
  __syncthreads();
  const XcdBarrier xb = xcd_barrier_post((unsigned*)(P.ws + OFF_BAR), (volatile LAS unsigned*)xb_st, wid_s);
  const bf16_t* ymix = (const bf16_t*)(P.ws + OFF_AR + 3 * SZ_U); const bf16_t* yffn = (const bf16_t*)(P.ws + OFF_AR);
#define PHASE_BEGIN if (ph >= P.lo && ph < P.hi) {
#define PHASE_END if (ph + 1 < P.hi) { if (P.lo < 0) grid.sync(); xcd_barrier(xb, wid_s); } } ++ph;
#ifndef PH_MASK
#define PH_MASK 0xffff
#endif
#define HAS(n) ((PH_MASK >> (n)) & 1)
#ifndef REP
#define REP 0
#endif
#define NREP(n) (((REP >> (n)) & 1) ? 2 : 1)
  PHASE_BEGIN
#if HAS(0)
    for (int rr = 0; rr < NREP(0); ++rr) mod_phase(P, lds, wid_s);
#endif
#if HAS(1)
    for (int rr = 0; rr < NREP(1); ++rr) { int base = 384; conv_mixer(P, 0, lds, base, wid_s); conv_ffn(P, 0, lds, base, wid_s); }
#endif
  PHASE_END
  for (int l = 0; l < 4; ++l) {
    const bool ret = (l & 1) == 0;
    PHASE_BEGIN
#if HAS(2)
      if (l == 0) pn_phase(P, -1, 0, 0, 0, true, nullptr, wid_s); else pn_phase(P, l - 1, 1, l, 0, false, yffn, wid_s);
#endif
#if HAS(1)
      if (l > 0) for (int rr = 0; rr < NREP(1); ++rr) { int base = 0; conv_ffn(P, l, lds, base, wid_s); }
#endif
    PHASE_END
    PHASE_BEGIN
#if HAS(3)
      for (int rr = 0; rr < NREP(3); ++rr) gemm_phase(P, ret ? GP_RET_IN : GP_DIFF_IN, lds, l, wid_s);
#endif
    PHASE_END
    if (ret) { PHASE_BEGIN
#if HAS(3)
      gemm_phase(P, GP_RET_S, lds, l, wid_s);
#endif
    PHASE_END }
    PHASE_BEGIN
#if HAS(4)
      if (ret) for (int rr = 0; rr < NREP(4); ++rr) ret_phase(P, l, lds, wid_s);
#endif
#if HAS(5)
      if (!ret) for (int rr = 0; rr < NREP(5); ++rr) att_phase(P, l, lds, wid_s);
#endif
    PHASE_END
    if (ret) { PHASE_BEGIN
#if HAS(3)
      for (int rr = 0; rr < NREP(3); ++rr) gemm_phase(P, GP_RET_GATE, lds, l, wid_s);
#endif
    PHASE_END }
    PHASE_BEGIN
#if HAS(3)
      for (int rr = 0; rr < NREP(3); ++rr) gemm_phase(P, ret ? GP_RET_OUT : GP_DIFF_OUT, lds, l, wid_s);
#endif
    PHASE_END
    PHASE_BEGIN
#if HAS(2)
      pn_phase(P, l, 0, l, 1, l == 0, ymix, wid_s);
#endif
#if HAS(1)
      if (l < 3) for (int rr = 0; rr < NREP(1); ++rr) { int base = 0; conv_mixer(P, l + 1, lds, base, wid_s); }
#endif
    PHASE_END
    PHASE_BEGIN
#if HAS(3)
      for (int rr = 0; rr < NREP(3); ++rr) gemm_phase(P, GP_FFN_UP, lds, l, wid_s);
#endif
    PHASE_END
    PHASE_BEGIN
#if HAS(3)
      for (int rr = 0; rr < NREP(3); ++rr) gemm_phase(P, GP_FFN_DOWN, lds, l, wid_s);
#endif
    PHASE_END
  }
  PHASE_BEGIN
#if HAS(2)
    pn_phase(P, 3, 1, -1, 0, false, yffn, wid_s);
#endif
  PHASE_END
}
constexpr int N_PHASES = 1 + 9 + 7 + 9 + 7 + 1;
#ifdef STOP_AT
__global__ void dump_kernel(const unsigned short* ws, float* out, size_t nws16) {
  size_t i = (size_t)blockIdx.x * 256 + threadIdx.x;
  unsigned acc = 0;
  for (size_t j = i; j < nws16; j += (size_t)TL * 1024) acc = acc * 31u + ws[j];
  out[i] = (float)(acc & 0xFFFFu) * (1.f / 65536.f);
}
#endif

extern "C" void kernel_launch(void* const* d_in, const int* in_sizes, int n_in, void* d_out, int out_size, void* d_ws, size_t ws_size, hipStream_t stream) {
  static int grid_blocks = 0;
  if (!grid_blocks) {
    int dev = 0, cus = 0, per_cu = 0;
    hipGetDevice(&dev);
    hipDeviceGetAttribute(&cus, hipDeviceAttributeMultiprocessorCount, dev);
    hipOccupancyMaxActiveBlocksPerMultiprocessor(&per_cu, fwd_kernel, NTH, 0);
    if (per_cu > 2) per_cu = 2;
    if (per_cu < 1) per_cu = 1;
    grid_blocks = cus * per_cu;
  }
  if (ws_size < WS_NEED) fprintf(stderr, "workspace too small: %zu < %zu\n", ws_size, (size_t)WS_NEED);
  Params p{};
  const float** f = (const float**)&p;
  for (int i = 0; i < 22; ++i) f[i] = (const float*)d_in[i];
  p.out = (float*)d_out; p.ws = (char*)d_ws;
#if MULTI_LAUNCH
#ifdef STOP_AT
  for (int ph = 0; ph < STOP_AT; ++ph) { p.lo = ph; p.hi = ph + 1; hipLaunchKernelGGL(fwd_kernel, dim3(grid_blocks), dim3(NTH), 0, stream, p); }
  hipLaunchKernelGGL(dump_kernel, dim3(TL * 1024 / 256), dim3(256), 0, stream, (const unsigned short*)d_ws, (float*)d_out, (size_t)WS_NEED / 2);
#else
  for (int ph = 0; ph < N_PHASES; ++ph) { p.lo = ph; p.hi = ph + 1; hipLaunchKernelGGL(fwd_kernel, dim3(grid_blocks), dim3(NTH), 0, stream, p); }
#endif
#else
  p.lo = 0; p.hi = N_PHASES;
  hipMemsetAsync((char*)d_ws + OFF_BAR, 0, 16384, stream);
  void* args[] = {&p};
  hipError_t e = hipLaunchCooperativeKernel((void*)fwd_kernel, dim3(grid_blocks), dim3(NTH), args, 0, stream);
  if (e != hipSuccess) fprintf(stderr, "cooperative launch failed: %s (grid %d)\n", hipGetErrorString(e), grid_blocks);
#endif
}
```

```cpp
#include <hip/hip_runtime.h>
#include <hip/hip_cooperative_groups.h>
#include <cstdio>
#include <cstdint>
namespace cg = cooperative_groups;

#ifndef MULTI_LAUNCH
#define MULTI_LAUNCH 0
#endif

typedef unsigned short bf16_t;
typedef short bf16x8 __attribute__((ext_vector_type(8)));
typedef short s16x4 __attribute__((ext_vector_type(4)));
typedef float f32x16 __attribute__((ext_vector_type(16)));
typedef float f32x4 __attribute__((ext_vector_type(4)));
typedef float f32x2 __attribute__((ext_vector_type(2)));
typedef unsigned u32x4 __attribute__((ext_vector_type(4)));
typedef unsigned u32x2 __attribute__((ext_vector_type(2)));
typedef __bf16 bf2_t __attribute__((ext_vector_type(2)));

#define DI __device__ __forceinline__
typedef __attribute__((address_space(3))) unsigned lds_u32_t;
#define GLDS(gp, lp) __builtin_amdgcn_global_load_lds((const unsigned*)(gp), (lds_u32_t*)(lp), 16, 0, 0)
#define MFMA(a, b, c) __builtin_amdgcn_mfma_f32_32x32x16_bf16((a), (b), (c), 0, 0, 0)

constexpr int T = 17408, TL = 16384, DM = 1024, NTH = 256;
constexpr float EPS = 1e-6f;
constexpr size_t SZ_U = (size_t)T * 1024 * 2;
constexpr size_t OFF_MOD = 0;
constexpr size_t OFF_TABR = OFF_MOD + 4 * 5 * 6144 * 4;
constexpr size_t OFF_TABD = OFF_TABR + 64 * 64 * 8;
constexpr size_t OFF_SSQ = OFF_TABD + 64 * 16 * 8;
constexpr size_t OFF_HC = OFF_SSQ + (size_t)T * 64 * 4 * 2;
constexpr size_t OFF_U = OFF_HC + 1024 * 1024 * 4;
constexpr size_t OFF_WM = OFF_U + SZ_U;
constexpr size_t OFF_WF = OFF_WM + (size_t)8192 * 1024 * 2 + (size_t)1024 * 2048 * 2;
constexpr size_t OFF_AR = OFF_WF + (size_t)5632 * 1024 * 2 + (size_t)1024 * 2816 * 2;
constexpr size_t OFF_BAR = OFF_AR + 9 * SZ_U;
constexpr size_t WS_NEED = OFF_BAR + 16384;

struct Params {
  const float *x, *c, *ctx, *c_ctx, *ada_w, *ada_b, *norm_g, *ret_w_in, *ret_w_out, *ret_df, *ret_db;
  const float *diff_w_in, *diff_w_out, *lq1, *lk1, *lq2, *lk2, *subln, *ffn_up, *ffn_cw, *ffn_cb, *ffn_down;
  float* out; char* ws; int lo, hi;
};

DI unsigned pk2(float lo, float hi) { f32x2 v = {lo, hi}; bf2_t b = __builtin_convertvector(v, bf2_t); return __builtin_bit_cast(unsigned, b); }
DI bf16_t f2bf(float x) { return (bf16_t)(pk2(x, 0.f) & 0xffffu); }
DI float bflo(unsigned u) { return __uint_as_float(u << 16); }
DI float bfhi(unsigned u) { return __uint_as_float(u & 0xffff0000u); }
DI float bf2f(bf16_t x) { return __uint_as_float((unsigned)x << 16); }
DI int crow(int reg, int h) { return (reg & 3) + 8 * (reg >> 2) + 4 * h; }
DI float ex2(float x) { return __builtin_amdgcn_exp2f(x); }
DI float wsum(float v) { for (int m = 32; m >= 1; m >>= 1) v += __shfl_xor(v, m); return v; }
DI float siluf(float x) { return x * __builtin_amdgcn_rcpf(1.f + __expf(-x)); }
DI bf16x8 pack8(const f32x16& x, int s) {
  u32x4 p; p.x = pk2(x[8 * s], x[8 * s + 1]); p.y = pk2(x[8 * s + 2], x[8 * s + 3]); p.z = pk2(x[8 * s + 4], x[8 * s + 5]); p.w = pk2(x[8 * s + 6], x[8 * s + 7]);
  return __builtin_bit_cast(bf16x8, p);
}
DI int lane_id() { return (int)__builtin_amdgcn_mbcnt_hi(~0u, __builtin_amdgcn_mbcnt_lo(~0u, 0u)); }
DI int otid_w(int wid_s) { int t = (wid_s << 6) | lane_id(); asm volatile("" : "+v"(t)); return t; }
#define otid() otid_w(wid_s)
DI f32x2 rope_cs(int pos, int fi, float cexp) {
  const float ang = (float)pos * ex2(-(float)fi * cexp);
  const float rev = ang * 0.15915494309189535f;
  const float fr = rev - rintf(rev);
  f32x2 cs; cs.x = __builtin_amdgcn_cosf(fr); cs.y = __builtin_amdgcn_sinf(fr); return cs;
}
#define XB_TMO      128
#define XB_XCNT(j)  (256  + 64 * (j))
#define XB_XSUB(j)  (1280 + 64 * (j))
#define XB_XGEN(j)  (2304 + 64 * (j))
#define XB_TOP      3328
#define XB_TOPGEN   3392
#define XB_SPIN_CAP (1u << 22)
#define LAS __attribute__((address_space(3)))
DI unsigned xb_ld(unsigned* p) { return __hip_atomic_load(p, __ATOMIC_RELAXED, __HIP_MEMORY_SCOPE_AGENT); }
DI unsigned xb_add(unsigned* p, unsigned v) { return __hip_atomic_fetch_add(p, v, __ATOMIC_RELAXED, __HIP_MEMORY_SCOPE_AGENT); }
DI unsigned xb_xcc_id() { return (unsigned)__builtin_amdgcn_s_getreg((3 << 11) | 20) & 0xFu; }
#define XB_SPIN(cond, bar) do { unsigned _sp = 0; while (cond) { __builtin_amdgcn_s_sleep(1); \
    if ((++_sp & 255u) == 0u) { if (xb_ld(&(bar)[XB_TMO])) break; if (_sp > XB_SPIN_CAP) { atomicAdd(&(bar)[XB_TMO], 1u); break; } } } } while (0)
struct XcdBarrier { unsigned* bar; unsigned x; volatile LAS unsigned* st; };
DI XcdBarrier xcd_barrier_post(unsigned* bar, volatile LAS unsigned* st, int wid_s) {
  XcdBarrier b; b.bar = bar; b.x = xb_xcc_id(); b.st = st;
  if (wid_s == 0 && lane_id() == 0) (void)xb_add(&bar[XB_XCNT(b.x)], 1u);
  return b;
}
DI void xcd_barrier_complete(unsigned* bar, unsigned x, unsigned& nloc, unsigned& nx) {
  const unsigned G = gridDim.x;
  unsigned sum, cnt, mine, sp = 0u;
  for (;;) {
    sum = 0u; cnt = 0u; mine = 0u;
#pragma unroll
    for (unsigned j = 0; j < 16; ++j) { const unsigned c = xb_ld(&bar[XB_XCNT(j)]); sum += c; cnt += (c > 0u) ? 1u : 0u; mine = (j == x) ? c : mine; }
    if (sum == G) break;
    __builtin_amdgcn_s_sleep(1);
    if ((++sp & 255u) == 0u) { if (xb_ld(&bar[XB_TMO])) break; if (sp > XB_SPIN_CAP) { atomicAdd(&bar[XB_TMO], 1u); break; } }
  }
  nloc = mine > 0u ? mine : 1u; nx = cnt > 0u ? cnt : 1u;
}
DI void xcd_barrier(const XcdBarrier& b, int wid_s) {
  asm volatile("s_waitcnt vmcnt(0)" ::: "memory");
  __syncthreads();
  if (wid_s == 0 && lane_id() == 0) {
    unsigned* bar = b.bar;
    __builtin_amdgcn_s_waitcnt(0);
    unsigned nloc = b.st[0], nx = b.st[1];
    if (nloc == 0u) { xcd_barrier_complete(bar, b.x, nloc, nx); b.st[0] = nloc; b.st[1] = nx; }
    const unsigned old = xb_add(&bar[XB_XSUB(b.x)], 1u);
    const unsigned gen = old / nloc;
    if (old + 1u == (gen + 1u) * nloc) {
      __builtin_amdgcn_fence(__ATOMIC_RELEASE, "agent");
      asm volatile("s_waitcnt vmcnt(0)" ::: "memory");
      const unsigned og = xb_add(&bar[XB_TOP], 1u);
      const unsigned tg = og / nx;
      if (og + 1u == (tg + 1u) * nx) xb_add(&bar[XB_TOPGEN], 1u);
      else XB_SPIN(xb_ld(&bar[XB_TOPGEN]) == tg, bar);
      __builtin_amdgcn_fence(__ATOMIC_ACQUIRE, "agent");
      xb_add(&bar[XB_XGEN(b.x)], 1u);
      asm volatile("s_waitcnt vmcnt(0)" ::: "memory");
    } else {
      XB_SPIN(xb_ld(&bar[XB_XGEN(b.x)]) == gen, bar);
      __builtin_amdgcn_fence(__ATOMIC_ACQUIRE, "agent");
      asm volatile("s_waitcnt vmcnt(0)" ::: "memory");
    }
  }
  __syncthreads();
}
template <int CTRL> DI float dpp_xadd(float x) { return x + __int_as_float(__builtin_amdgcn_update_dpp(0, __float_as_int(x), CTRL, 0xF, 0xF, true)); }
DI int rowbsel(int row) { return row < TL ? (row >> 12) : 4; }

DI int srccol(int g, int mode) {
  if (mode == 1) {
    if (g < 2048) return (g & ~127) + 32 * ((g >> 6) & 1) + (g & 31) + 64 * ((g >> 5) & 1);
    if (g < 4096) return g;
    int gp = g - 4096; return 4096 + 2048 * ((gp >> 5) & 1) + 32 * (gp >> 6) + (gp & 31);
  }
  if (mode == 2) {
    if (g < 2048) { int c = g & 31; return (g & ~63) + (c < 16 ? c : c + 16) + 16 * ((g >> 5) & 1); }
    return g;
  }
  if (mode == 3) return 64 * (g >> 7) + (g & 63) + 2816 * ((g >> 6) & 1);
  return g;
}
DI void conv_range(const float* __restrict__ src, int nsrc, bf16_t* __restrict__ dst, int K, int nrows, int mode, char* lds, int& base, int wid_s) {
  float (*tile)[65] = (float (*)[65])lds;
  const int tid = otid(), nkb = K >> 6, nitems = (nrows >> 6) * nkb, G = gridDim.x;
  int it = (int)((blockIdx.x + G - (base % G)) % G);
  float r[16];
  if (it < nitems) {
    const int g0 = (it / nkb) * 64, k0 = (it % nkb) * 64;
#pragma unroll
    for (int i = 0; i < 16; ++i) { int e = tid + 256 * i, kk = e >> 6, gg = e & 63; r[i] = src[(size_t)(k0 + kk) * nsrc + srccol(g0 + gg, mode)]; }
  }
  for (; it < nitems; it += G) {
    const int g0 = (it / nkb) * 64, k0 = (it % nkb) * 64;
#pragma unroll
    for (int i = 0; i < 16; ++i) { int e = tid + 256 * i, kk = e >> 6, gg = e & 63; tile[kk][gg] = r[i]; }
    __syncthreads();
    if (it + G < nitems) {
      const int g1 = ((it + G) / nkb) * 64, k1 = ((it + G) % nkb) * 64;
#pragma unroll
      for (int i = 0; i < 16; ++i) { int e = tid + 256 * i, kk = e >> 6, gg = e & 63; r[i] = src[(size_t)(k1 + kk) * nsrc + srccol(g1 + gg, mode)]; }
    }
    const int gg = tid >> 2, kq = (tid & 3) * 16;
    u32x4 w0, w1;
    w0.x = pk2(tile[kq + 0][gg], tile[kq + 1][gg]); w0.y = pk2(tile[kq + 2][gg], tile[kq + 3][gg]); w0.z = pk2(tile[kq + 4][gg], tile[kq + 5][gg]); w0.w = pk2(tile[kq + 6][gg], tile[kq + 7][gg]);
    w1.x = pk2(tile[kq + 8][gg], tile[kq + 9][gg]); w1.y = pk2(tile[kq + 10][gg], tile[kq + 11][gg]); w1.z = pk2(tile[kq + 12][gg], tile[kq + 13][gg]); w1.w = pk2(tile[kq + 14][gg], tile[kq + 15][gg]);
    bf16_t* d = dst + (size_t)(g0 + gg) * K + k0 + kq;
    *(u32x4*)d = w0; *(u32x4*)(d + 8) = w1;
    __syncthreads();
  }
  base += nitems;
}
DI void conv_mixer(const Params& P, int l, char* lds, int& base, int wid_s) {
  bf16_t* WM = (bf16_t*)(P.ws + OFF_WM); const int i = l >> 1;
  if ((l & 1) == 0) {
    conv_range(P.ret_w_in + (size_t)i * 1024 * 8192, 8192, WM, 1024, 8192, 1, lds, base, wid_s);
    conv_range(P.ret_w_out + (size_t)i * 2048 * 1024, 1024, WM + (size_t)8192 * 1024, 2048, 1024, 0, lds, base, wid_s);
  } else {
    conv_range(P.diff_w_in + (size_t)i * 1024 * 3072, 3072, WM, 1024, 3072, 2, lds, base, wid_s);
    conv_range(P.diff_w_out + (size_t)i * 1024 * 1024, 1024, WM + (size_t)3072 * 1024, 1024, 1024, 0, lds, base, wid_s);
  }
}
DI void conv_ffn(const Params& P, int l, char* lds, int& base, int wid_s) {
  bf16_t* WF = (bf16_t*)(P.ws + OFF_WF);
  conv_range(P.ffn_up + (size_t)l * 1024 * 5632, 5632, WF, 1024, 5632, 3, lds, base, wid_s);
  conv_range(P.ffn_down + (size_t)l * 2816 * 1024, 1024, WF + (size_t)5632 * 1024, 2816, 1024, 0, lds, base, wid_s);
}

DI void mod_phase(const Params& P, char* lds, int wid_s) {
  const int tid = otid();
  float* sc = (float*)lds; float* red = (float*)(lds + 20480);
  float* mod = (float*)(P.ws + OFF_MOD);
  for (int e = tid; e < 5120; e += NTH) { int bs = e >> 10, k = e & 1023; float v = bs < 4 ? P.c[bs * 1024 + k] : P.c_ctx[k]; sc[e] = v / (1.f + __expf(-v)); }
  __syncthreads();
  for (int item = blockIdx.x; item < 384; item += gridDim.x) {
    const int l = item / 96, cgp = item % 96, kq = tid >> 6, cl = tid & 63, col = cgp * 64 + cl;
    float a0 = 0, a1 = 0, a2 = 0, a3 = 0, a4 = 0;
    const float* w = P.ada_w + ((size_t)l * 1024 + kq * 256) * 6144 + col;
#pragma unroll 8
    for (int k = 0; k < 256; ++k) { float wv = w[(size_t)k * 6144]; int kk = kq * 256 + k; a0 += sc[kk] * wv; a1 += sc[1024 + kk] * wv; a2 += sc[2048 + kk] * wv; a3 += sc[3072 + kk] * wv; a4 += sc[4096 + kk] * wv; }
    red[(kq * 5 + 0) * 64 + cl] = a0; red[(kq * 5 + 1) * 64 + cl] = a1; red[(kq * 5 + 2) * 64 + cl] = a2; red[(kq * 5 + 3) * 64 + cl] = a3; red[(kq * 5 + 4) * 64 + cl] = a4;
    __syncthreads();
    for (int e = tid; e < 320; e += NTH) { int bs = e >> 6, c2 = e & 63; float s = red[(0 * 5 + bs) * 64 + c2] + red[(1 * 5 + bs) * 64 + c2] + red[(2 * 5 + bs) * 64 + c2] + red[(3 * 5 + bs) * 64 + c2];
      mod[(size_t)(l * 5 + bs) * 6144 + cgp * 64 + c2] = s + P.ada_b[l * 6144 + cgp * 64 + c2]; }
    __syncthreads();
  }
}

DI void pn_phase(const Params& P, int l_res, int which_res, int l_pre, int which_pre, bool h_from_input, const bf16_t* ybuf, int wid_s) {
  const int tid0 = otid(); const int lane = tid0 & 63, w = tid0 >> 6;
  const float* mod = (const float*)(P.ws + OFF_MOD);
  float* hc = (float*)(P.ws + OFF_HC); bf16_t* u = (bf16_t*)(P.ws + OFF_U);
  const int nrows = (l_pre < 0 || (l_res == 3 && which_res == 0)) ? TL : T;
  const int nw = gridDim.x * 4;
  for (int row0 = blockIdx.x * 4 + w; row0 < nrows; row0 += 2 * nw) {
    int rows[2] = {row0, row0 + nw};
    const bool has1 = rows[1] < nrows; if (!has1) rows[1] = row0;
    const float* hin[2]; float* hout[2]; int bs[2];
    f32x4 hv[2][4], yv[2][4];
#pragma unroll
    for (int k = 0; k < 2; ++k) {
      const int row = rows[k]; bs[k] = rowbsel(row);
      hin[k] = h_from_input ? (row < TL ? P.x + (size_t)row * 1024 : P.ctx + (size_t)(row - TL) * 1024)
                            : (row < TL ? P.out + (size_t)row * 1024 : hc + (size_t)(row - TL) * 1024);
      hout[k] = row < TL ? P.out + (size_t)row * 1024 : hc + (size_t)(row - TL) * 1024;
#pragma unroll
      for (int i = 0; i < 4; ++i) hv[k][i] = *(const f32x4*)(hin[k] + lane * 4 + 256 * i);
      if (l_res >= 0) {
#pragma unroll
        for (int i = 0; i < 4; ++i) {
          if (row < TL) { const u32x2 yr = *(const u32x2*)(ybuf + (size_t)row * 1024 + lane * 4 + 256 * i); yv[k][i] = (f32x4){bflo(yr.x), bfhi(yr.x), bflo(yr.y), bfhi(yr.y)}; }
          else {
            const float* yp = (const float*)(P.ws + OFF_AR + 4 * SZ_U) + (size_t)(row - TL) * 1024 + lane * 4 + 256 * i;
            yv[k][i] = (*(const f32x4*)yp + *(const f32x4*)(yp + 1024 * 1024)) + (*(const f32x4*)(yp + 2 * 1024 * 1024) + *(const f32x4*)(yp + 3 * 1024 * 1024));
          }
        }
      }
    }
#pragma unroll
    for (int k = 0; k < 2; ++k) {
      if (k == 1 && !has1) break;
      const int row = rows[k];
      if (l_res >= 0) {
        float ss = 0.f;
#pragma unroll
        for (int i = 0; i < 4; ++i) ss += yv[k][i].x * yv[k][i].x + yv[k][i].y * yv[k][i].y + yv[k][i].z * yv[k][i].z + yv[k][i].w * yv[k][i].w;
        ss = wsum(ss); const float rstd = rsqrtf(ss * (1.f / 1024.f) + EPS);
        const float* gate = mod + (size_t)(l_res * 5 + bs[k]) * 6144 + (which_res ? 5 : 2) * 1024;
        const float* gp = P.norm_g + (size_t)(l_res * 4 + (which_res ? 3 : 1)) * 1024;
#pragma unroll
        for (int i = 0; i < 4; ++i) { f32x4 gt = *(const f32x4*)(gate + lane * 4 + 256 * i), gg = *(const f32x4*)(gp + lane * 4 + 256 * i); hv[k][i] += gt * (yv[k][i] * rstd * gg); *(f32x4*)(hout[k] + lane * 4 + 256 * i) = hv[k][i]; }
      }
      if (l_pre >= 0) {
        float ss = 0.f;
#pragma unroll
        for (int i = 0; i < 4; ++i) ss += hv[k][i].x * hv[k][i].x + hv[k][i].y * hv[k][i].y + hv[k][i].z * hv[k][i].z + hv[k][i].w * hv[k][i].w;
        ss = wsum(ss); const float rstd = rsqrtf(ss * (1.f / 1024.f) + EPS);
        const float* g = P.norm_g + (size_t)(l_pre * 4 + (which_pre ? 2 : 0)) * 1024;
        const float* sh = mod + (size_t)(l_pre * 5 + bs[k]) * 6144 + (which_pre ? 3 : 0) * 1024;
        const float* scv = mod + (size_t)(l_pre * 5 + bs[k]) * 6144 + (which_pre ? 4 : 1) * 1024;
#pragma unroll
        for (int i = 0; i < 4; ++i) {
          f32x4 gg = *(const f32x4*)(g + lane * 4 + 256 * i), s1 = *(const f32x4*)(sh + lane * 4 + 256 * i), s2 = *(const f32x4*)(scv + lane * 4 + 256 * i);
          f32x4 o = (hv[k][i] * rstd * gg) * (s2 + 1.f) + s1;
          u32x2 pk; pk.x = pk2(o.x, o.y); pk.y = pk2(o.z, o.w);
          *(u32x2*)(u + (size_t)row * 1024 + lane * 4 + 256 * i) = pk;
        }
      }
    }
  }
}

DI void act_phase(const Params& P, int l, int wid_s) {
  const bf16_t* __restrict__ vg = (const bf16_t*)(P.ws + OFF_AR); bf16_t* __restrict__ a = (bf16_t*)(P.ws + OFF_AR + 6 * SZ_U);
  const float* cw = P.ffn_cw + (size_t)l * 3 * 2816; const float* cb = P.ffn_cb + (size_t)l * 2816;
  const int tid = otid();
  for (int item = blockIdx.x; item < 272 * 352 / 256; item += gridDim.x) {
    const int u = item * 256 + tid; const int br = u / 352, ch = u - br * 352;
    const int r = (br >> 1) * 128 + (br & 1) * 127;
    const int p = r < TL ? (r & 4095) : ((r - TL) & 255); const int slen = r < TL ? 4096 : 256;
    const int f0 = ch * 8;
    const bf16_t* gp = vg + (size_t)r * 5632 + 2816 + f0;
    u32x4 g0 = {0, 0, 0, 0}, g2 = {0, 0, 0, 0};
    if (p != 0) g0 = *(const u32x4*)(gp - 5632);
    if (p + 1 < slen) g2 = *(const u32x4*)(gp + 5632);
    const u32x4 g1 = *(const u32x4*)gp, vv = *(const u32x4*)(vg + (size_t)r * 5632 + f0);
    float o[8];
#pragma unroll
    for (int qd = 0; qd < 4; ++qd) {
      const float x0 = cw[f0 + 2 * qd] * bflo(g0[qd]) + cw[2816 + f0 + 2 * qd] * bflo(g1[qd]) + cw[5632 + f0 + 2 * qd] * bflo(g2[qd]) + cb[f0 + 2 * qd];
      const float x1 = cw[f0 + 2 * qd + 1] * bfhi(g0[qd]) + cw[2816 + f0 + 2 * qd + 1] * bfhi(g1[qd]) + cw[5632 + f0 + 2 * qd + 1] * bfhi(g2[qd]) + cb[f0 + 2 * qd + 1];
      o[2 * qd] = siluf(x0) * bflo(vv[qd]); o[2 * qd + 1] = siluf(x1) * bfhi(vv[qd]);
    }
    u32x4 ov; ov.x = pk2(o[0], o[1]); ov.y = pk2(o[2], o[3]); ov.z = pk2(o[4], o[5]); ov.w = pk2(o[6], o[7]);
    *(u32x4*)(a + (size_t)r * 2816 + f0) = ov;
  }
}

enum { EPI_F32 = 0, EPI_BF16 = 1, EPI_ROPE_RET_N = 2, EPI_ROPE_RET_T = 3, EPI_ROPE_DIFF_N = 4, EPI_MERGE = 5, EPI_SMASK = 6, EPI_ACT = 7 };
struct Job { const bf16_t* A; const bf16_t* B; int lda, ldb, K, m0, n0, epi, ldc, aux, afrag; void* out; float scale; };

DI void gemm_tile(const Params& P, const Job& J, char* lds, int tid) {
  const int lane = tid & 63, w = tid >> 6, wm = w >> 1, wn = w & 1, l31 = lane & 31, hi = lane >> 5;
  f32x16 acc[2][2];
#pragma unroll
  for (int a = 0; a < 2; ++a)
#pragma unroll
    for (int b = 0; b < 2; ++b)
#pragma unroll
      for (int r = 0; r < 16; ++r) acc[a][b][r] = 0.f;
  const int lrow = tid >> 3, lkc = (tid & 7) ^ ((tid >> 4) & 7);
  const bf16_t* ga = J.afrag ? J.A + ((((size_t)(J.m0 >> 5) * 4 + (J.afrag - 1)) * 16 + (lkc >> 1)) * 64 + (lkc & 1) * 32 + lrow) * 8
                             : J.A + (size_t)(J.m0 + lrow) * J.lda + lkc * 8;
  const bf16_t* gb = J.B + (size_t)(J.n0 + lrow) * J.ldb + lkc * 8;
  const size_t sa = J.afrag ? (size_t)32768 : (size_t)32 * J.lda, sb = (size_t)32 * J.ldb;
  const size_t ksa = J.afrag ? 2048 : 64;
  const int swz = (lane >> 1) & 7;
  const int aoff = (64 * wm + l31) * 128, boff = 16384 + (64 * wn + l31) * 128;
  const int nk = J.K >> 6;
  char* wbase = lds + tid * 16;
#pragma unroll
  for (int i = 0; i < 4; ++i) { GLDS(ga + i * sa, wbase + i * 4096); GLDS(gb + i * sb, wbase + 16384 + i * 4096); }
  asm volatile("s_waitcnt vmcnt(0)" ::: "memory");
  __syncthreads();
  for (int kt = 0; kt < nk; ++kt) {
    const char* cur = lds + (kt & 1) * 32768; char* nxt = wbase + ((kt + 1) & 1) * 32768;
    if (kt + 1 < nk) {
#pragma unroll
      for (int i = 0; i < 4; ++i) { GLDS(ga + (size_t)(kt + 1) * ksa + i * sa, nxt + i * 4096); GLDS(gb + (size_t)(kt + 1) * 64 + i * sb, nxt + 16384 + i * 4096); }
    }
    bf16x8 fa[2][2], fb[2][2];
    { const int ko = ((0 + hi) ^ swz) << 4;
      fa[0][0] = *(const bf16x8*)(cur + aoff + ko); fa[0][1] = *(const bf16x8*)(cur + aoff + 4096 + ko);
      fb[0][0] = *(const bf16x8*)(cur + boff + ko); fb[0][1] = *(const bf16x8*)(cur + boff + 4096 + ko); }
#pragma unroll
    for (int s = 0; s < 4; ++s) {
      const int c = s & 1, n = c ^ 1;
      if (s < 3) {
        const int ko = ((2 * (s + 1) + hi) ^ swz) << 4;
        fa[n][0] = *(const bf16x8*)(cur + aoff + ko); fa[n][1] = *(const bf16x8*)(cur + aoff + 4096 + ko);
        fb[n][0] = *(const bf16x8*)(cur + boff + ko); fb[n][1] = *(const bf16x8*)(cur + boff + 4096 + ko);
      }
      acc[0][0] = MFMA(fa[c][0], fb[c][0], acc[0][0]); acc[0][1] = MFMA(fa[c][0], fb[c][1], acc[0][1]);
      acc[1][0] = MFMA(fa[c][1], fb[c][0], acc[1][0]); acc[1][1] = MFMA(fa[c][1], fb[c][1], acc[1][1]);
      __builtin_amdgcn_sched_barrier(0);
    }
    asm volatile("s_waitcnt vmcnt(0)" ::: "memory");
    __syncthreads();
  }
  int l31e = l31, hie = hi; asm volatile("" : "+v"(l31e), "+v"(hie));
  const int m0w = J.m0 + 64 * wm, n0w = J.n0 + 64 * wn;
  if (J.epi == EPI_F32) {
    float* o = (float*)J.out;
#pragma unroll
    for (int tm = 0; tm < 2; ++tm)
#pragma unroll
      for (int tn = 0; tn < 2; ++tn)
#pragma unroll
        for (int r = 0; r < 16; ++r) o[(size_t)(m0w + 32 * tm + crow(r, hie)) * J.ldc + n0w + 32 * tn + l31e] = acc[tm][tn][r];
    return;
  }
  constexpr int IST = 272;
  char* img = lds;
  bf16_t* obase; size_t oldc; int ocols = 128, ist = IST;
  if (J.epi == EPI_BF16) {
#pragma unroll
    for (int tm = 0; tm < 2; ++tm)
#pragma unroll
      for (int tn = 0; tn < 2; ++tn)
#pragma unroll
        for (int r = 0; r < 16; ++r) {
          int cl = 64 * wn + 32 * tn + l31e;
          if (J.aux & 1) cl = (cl & ~12) | ((cl & 4) << 1) | ((cl & 8) >> 1);
          *(bf16_t*)(img + (64 * wm + 32 * tm + crow(r, hie)) * IST + cl * 2) = f2bf(acc[tm][tn][r]);
        }
    obase = (bf16_t*)J.out + (size_t)J.m0 * J.ldc + J.n0; oldc = J.ldc;
  } else if (J.epi == EPI_ROPE_RET_N) {
    const int g128 = n0w >> 7, fi = 32 * wn + l31e;
#pragma unroll
    for (int tm = 0; tm < 2; ++tm)
#pragma unroll
      for (int r = 0; r < 16; ++r) {
        const int rl = 64 * wm + 32 * tm + crow(r, hie), row = J.m0 + rl;
        float x1 = acc[tm][0][r], x2 = acc[tm][1][r];
        if (row < TL) { const int pos = (g128 & 1) ? (row & 63) : ((row >> 6) & 63); const f32x2 cs = rope_cs(pos, fi, 13.287712379549449f / 64.f); const float y1 = x1 * cs.x - x2 * cs.y, y2 = x1 * cs.y + x2 * cs.x; x1 = y1; x2 = y2; }
        *(bf16_t*)(img + rl * IST + fi * 2) = f2bf(x1 * J.scale); *(bf16_t*)(img + rl * IST + (fi + 64) * 2) = f2bf(x2 * J.scale);
      }
    obase = (bf16_t*)J.out + (size_t)J.m0 * 1024 + J.n0; oldc = 1024;
  } else if (J.epi == EPI_ROPE_RET_T) {
    const int g128 = m0w >> 7;
#pragma unroll
    for (int tn = 0; tn < 2; ++tn) {
      const int cl = 64 * wn + 32 * tn + l31e, tok = J.n0 + cl; const int pos = (g128 & 1) ? (tok & 63) : ((tok >> 6) & 63);
#pragma unroll
      for (int r = 0; r < 16; ++r) {
        const int fi = 32 * wm + crow(r, hie);
        float x1 = acc[0][tn][r], x2 = acc[1][tn][r];
        if (tok < TL) { const f32x2 cs = rope_cs(pos, fi, 13.287712379549449f / 64.f); const float y1 = x1 * cs.x - x2 * cs.y, y2 = x1 * cs.y + x2 * cs.x; x1 = y1; x2 = y2; }
        *(bf16_t*)(img + fi * IST + cl * 2) = f2bf(x1 * J.scale); *(bf16_t*)(img + (fi + 64) * IST + cl * 2) = f2bf(x2 * J.scale);
      }
    }
    obase = (bf16_t*)J.out + (size_t)J.m0 * T + J.n0; oldc = T;
  } else if (J.epi == EPI_ROPE_DIFF_N) {
    const int fi = l31e & 15, c1 = 64 * wn + (l31e < 16 ? l31e : l31e + 16);
#pragma unroll
    for (int tm = 0; tm < 2; ++tm)
#pragma unroll
      for (int r = 0; r < 16; ++r) {
        const int rl = 64 * wm + 32 * tm + crow(r, hie), row = J.m0 + rl;
        float x1 = acc[tm][0][r], x2 = acc[tm][1][r];
        if (row < TL) { const int pos = (l31e < 16) ? ((row >> 6) & 63) : (row & 63); const f32x2 cs = rope_cs(pos, fi, 13.287712379549449f / 16.f); const float y1 = x1 * cs.x - x2 * cs.y, y2 = x1 * cs.y + x2 * cs.x; x1 = y1; x2 = y2; }
        *(bf16_t*)(img + rl * IST + c1 * 2) = f2bf(x1); *(bf16_t*)(img + rl * IST + (c1 + 16) * 2) = f2bf(x2);
      }
    obase = (bf16_t*)J.out + (size_t)J.m0 * 1024 + J.n0; oldc = 1024;
  } else if (J.epi == EPI_SMASK) {
    const int il4 = J.aux, hh = il4 & 3;
    const float lgf = -log2f(1.f + expf(-P.ret_df[il4])), lgb = -log2f(1.f + expf(-P.ret_db[il4]));
#pragma unroll
    for (int d = 0; d < 2; ++d) {
#pragma unroll
      for (int tm = 0; tm < 2; ++tm)
#pragma unroll
        for (int tn = 0; tn < 2; ++tn)
#pragma unroll
          for (int r = 0; r < 16; ++r) {
            const int i = 64 * wm + 32 * tm + crow(r, hie), j = 64 * wn + 32 * tn + l31e, dd = d ? j - i : i - j;
            const float v = dd >= 0 ? acc[tm][tn][r] * ex2((d ? lgb : lgf) * (float)dd) : 0.f;
            *(bf16_t*)(img + i * IST + j * 2) = f2bf(v);
          }
      __syncthreads();
      bf16_t* ob2 = (bf16_t*)J.out + (size_t)J.m0 * 1024 + hh * 256 + d * 128;
#pragma unroll
      for (int i = 0; i < 8; ++i) { const int c = tid + 256 * i, row = c >> 4, cc = c & 15, hb = ((d * 4 + (row >> 5)) * 8 + (cc >> 1)) * 2 + (cc & 1);
        *(u32x4*)((bf16_t*)J.out + (size_t)(J.m0 + hb) * 1024 + hh * 256 + (row & 31) * 8) = *(const u32x4*)(img + row * IST + cc * 16); }
      __syncthreads();
    }
    return;
  } else if (J.epi == EPI_ACT) {
#pragma unroll
    for (int tm = 0; tm < 2; ++tm)
#pragma unroll
      for (int tn = 0; tn < 2; ++tn)
#pragma unroll
        for (int r = 0; r < 16; ++r) *(bf16_t*)(img + (64 * wm + 32 * tm + crow(r, hie)) * IST + (64 * wn + 32 * tn + l31e) * 2) = f2bf(acc[tm][tn][r]);
    __syncthreads();
    {
      const int ch = tid & 7, rg = tid >> 3, f0 = 64 * (J.n0 >> 7) + 8 * ch;
      const float* cw = P.ffn_cw + (size_t)J.aux * 3 * 2816; const float* cb = P.ffn_cb + (size_t)J.aux * 2816;
      float w0[8], w1[8], w2[8], bb[8];
#pragma unroll
      for (int j = 0; j < 8; ++j) { w0[j] = cw[f0 + j]; w1[j] = cw[2816 + f0 + j]; w2[j] = cw[5632 + f0 + j]; bb[j] = cb[f0 + j]; }
      const int slen = J.m0 < TL ? 4096 : 256, p0 = J.m0 < TL ? (J.m0 & 4095) : ((J.m0 - TL) & 255);
      const bool sstart = p0 == 0, send = p0 + 128 == slen;
      u32x4 g[6], vv[4];
#pragma unroll
      for (int qd = 0; qd < 6; ++qd) { const int lr = 4 * rg - 1 + qd; g[qd] = (u32x4){0, 0, 0, 0}; if (lr >= 0 && lr < 128) g[qd] = *(const u32x4*)(img + lr * IST + (64 + 8 * ch) * 2); }
#pragma unroll
      for (int qd = 0; qd < 4; ++qd) vv[qd] = *(const u32x4*)(img + (4 * rg + qd) * IST + 8 * ch * 2);
      bf16_t* aout = (bf16_t*)J.out; bf16_t* vgb = (bf16_t*)(P.ws + OFF_AR);
#pragma unroll
      for (int qd = 0; qd < 4; ++qd) {
        const int lr = 4 * rg + qd;
        float o[8];
#pragma unroll
        for (int k2 = 0; k2 < 4; ++k2) {
          const float x0 = w0[2 * k2] * bflo(g[qd][k2]) + w1[2 * k2] * bflo(g[qd + 1][k2]) + w2[2 * k2] * bflo(g[qd + 2][k2]) + bb[2 * k2];
          const float x1 = w0[2 * k2 + 1] * bfhi(g[qd][k2]) + w1[2 * k2 + 1] * bfhi(g[qd + 1][k2]) + w2[2 * k2 + 1] * bfhi(g[qd + 2][k2]) + bb[2 * k2 + 1];
          o[2 * k2] = siluf(x0) * bflo(vv[qd][k2]); o[2 * k2 + 1] = siluf(x1) * bfhi(vv[qd][k2]);
        }
        if ((lr > 0 || sstart) && (lr < 127 || send)) {
          u32x4 ov; ov.x = pk2(o[0], o[1]); ov.y = pk2(o[2], o[3]); ov.z = pk2(o[4], o[5]); ov.w = pk2(o[6], o[7]);
          *(u32x4*)(aout + (size_t)(J.m0 + lr) * 2816 + f0) = ov;
        }
        if (lr < 2 || lr > 125) {
          *(u32x4*)(vgb + (size_t)(J.m0 + lr) * 5632 + f0) = vv[qd];
          *(u32x4*)(vgb + (size_t)(J.m0 + lr) * 5632 + 2816 + f0) = g[qd + 1];
        }
      }
    }
    __syncthreads();
    return;
  } else {
    constexpr int MST = 144;
    char* oft = lds + 18432; char* obt = lds + 36864; float* rs = (float*)(lds + 55296);
    const int f0 = J.n0 >> 1, hd = f0 >> 9;
    const bf16_t* of = (const bf16_t*)(P.ws + OFF_AR + 5 * SZ_U); const bf16_t* ob = (const bf16_t*)(P.ws + OFF_AR + 7 * SZ_U);
    {
      const int row = tid & 127, dir = tid >> 7;
      const float* sp = (const float*)(P.ws + OFF_SSQ) + (dir ? (size_t)T * 64 : 0) + ((size_t)(J.m0 + row) * 4 + hd) * 16;
      float sm = 0.f;
#pragma unroll
      for (int qd = 0; qd < 4; ++qd) { const f32x4 pv = *(const f32x4*)(sp + 4 * qd); sm += (pv.x + pv.y) + (pv.z + pv.w); }
      rs[tid] = rsqrtf(sm * (1.f / 512.f) + EPS);
#pragma unroll
      for (int i = 0; i < 4; ++i) {
        const int c = tid + 256 * i, r2 = c >> 3, cc = c & 7;
        *(u32x4*)(oft + r2 * MST + cc * 16) = *(const u32x4*)(of + (size_t)(J.m0 + r2) * 2048 + f0 + cc * 8);
        *(u32x4*)(obt + r2 * MST + cc * 16) = *(const u32x4*)(ob + (size_t)(J.m0 + r2) * 2048 + f0 + cc * 8);
      }
    }
    __syncthreads();
    const int cl = 32 * wn + l31e;
#pragma unroll
    for (int tm = 0; tm < 2; ++tm)
#pragma unroll
      for (int r = 0; r < 16; ++r) {
        const int rl = 64 * wm + 32 * tm + crow(r, hie);
        const float vf = bf2f(*(const bf16_t*)(oft + rl * MST + cl * 2)) * rs[rl], vb = bf2f(*(const bf16_t*)(obt + rl * MST + cl * 2)) * rs[128 + rl];
        *(bf16_t*)(img + rl * MST + cl * 2) = f2bf(siluf(acc[tm][0][r]) * vf + siluf(acc[tm][1][r]) * vb);
      }
    obase = (bf16_t*)J.out + (size_t)J.m0 * 2048 + f0; oldc = 2048; ocols = 64; ist = MST;
  }
  __syncthreads();
  if (ocols == 128 && (J.aux & 2)) {
    const int ci = J.n0 >> 7;
#pragma unroll
    for (int i = 0; i < 8; ++i) {
      const int c = tid + 256 * i, row = c >> 4, cc = c & 15, gt = (J.m0 + row) >> 5;
      bf16_t* dst = (bf16_t*)J.out + ((((size_t)gt * 136 + ci) * 8 + (cc >> 1)) * 64 + (cc & 1) * 32 + (row & 31)) * 8;
      *(u32x4*)dst = *(const u32x4*)(img + row * ist + cc * 16);
    }
  } else if (ocols == 128 && (J.aux & 8)) {
    const int hq = J.n0 >> 8, s0 = ((J.n0 >> 7) & 1) * 8;
#pragma unroll
    for (int i = 0; i < 8; ++i) {
      const int c = tid + 256 * i, row = c >> 4, cc = c & 15, rt = (J.m0 + row) >> 5;
      bf16_t* dst = (bf16_t*)J.out + ((((size_t)rt * 4 + hq) * 16 + s0 + (cc >> 1)) * 64 + (cc & 1) * 32 + (row & 31)) * 8;
      *(u32x4*)dst = *(const u32x4*)(img + row * ist + cc * 16);
    }
  } else if (ocols == 128) {
#pragma unroll
    for (int i = 0; i < 8; ++i) { const int c = tid + 256 * i, row = c >> 4, cc = c & 15; *(u32x4*)(obase + (size_t)row * oldc + cc * 8) = *(const u32x4*)(img + row * ist + cc * 16); }
  } else {
#pragma unroll
    for (int i = 0; i < 4; ++i) { const int c = tid + 256 * i, row = c >> 3, cc = c & 7; *(u32x4*)(obase + (size_t)row * oldc + cc * 8) = *(const u32x4*)(img + row * ist + cc * 16); }
  }
  __syncthreads();
}

DI void tile_mn(int idx, int nN, int& tm, int& tn) { const int per = 8 * nN, mg = idx / per, rem = idx % per; tn = rem >> 3; tm = mg * 8 + (rem & 7); }

enum { GP_RET_IN = 0, GP_RET_GATE, GP_RET_OUT, GP_DIFF_IN, GP_DIFF_OUT, GP_FFN_UP, GP_FFN_DOWN, GP_RET_S };
DI void gemm_phase(const Params& P, int kind, char* lds, int layer, int wid_s) {
  const bf16_t* U = (const bf16_t*)(P.ws + OFF_U); const bf16_t* WM = (const bf16_t*)(P.ws + OFF_WM); const bf16_t* WF = (const bf16_t*)(P.ws + OFF_WF);
  char* AR = P.ws + OFF_AR;
  int total;
  switch (kind) {
    case GP_RET_IN: total = 1088 * 5; break;
    case GP_RET_S: total = 544; break;
    case GP_RET_GATE: total = 136 * 32; break;
    case GP_DIFF_IN: total = 1088 * 3; break;
    case GP_FFN_UP: total = (layer == 3 ? 128 : 136) * 44; break;
    default: total = layer == 3 ? 1024 : 1024 + 256; break;
  }
  const int G = gridDim.x, per = G >> 3; const int tid = otid();
  for (int base = 0; base < total; base += G) {
    int L = base + ((G & 7) == 0 ? (int)(blockIdx.x & 7) * per + (int)(blockIdx.x >> 3) : (int)blockIdx.x);
    if (L >= total) continue;
    Job J; J.lda = 1024; J.ldb = 1024; J.K = 1024; J.scale = 1.f; J.ldc = 1024; J.aux = 0; J.afrag = 0;
    int tm, tn;
    if (kind == GP_RET_S) { const int hh = L & 3, ci = L >> 2; tm = ci; tn = ci; J.A = (const bf16_t*)AR; J.afrag = 1 + hh; J.B = (const bf16_t*)(AR + SZ_U) + hh * 256; J.K = 256; J.epi = EPI_SMASK; J.out = AR + SZ_U; J.aux = (layer >> 1) * 4 + hh; }
    else if (kind == GP_RET_IN) {
      if (L < 1088) { tile_mn(L, 8, tm, tn); J.A = U; J.B = WM; J.epi = EPI_ROPE_RET_N; J.out = AR; J.aux = 8; }
      else if (L < 2176) { tile_mn(L - 1088, 8, tm, tn); J.A = U; J.B = WM + (size_t)1024 * 1024; J.epi = EPI_ROPE_RET_N; J.out = AR + SZ_U; J.scale = 0.0625f; }
      else if (L < 3264) { tile_mn(L - 2176, 136, tm, tn); J.A = WM + (size_t)1024 * 1024; J.B = U; J.epi = EPI_ROPE_RET_T; J.out = AR + 2 * SZ_U; J.scale = 0.0625f; J.aux = 2; }
      else { tile_mn(L - 3264, 136, tm, tn); J.A = WM + (size_t)2048 * 1024; J.B = U; J.epi = EPI_BF16; J.out = AR + 3 * SZ_U; J.ldc = T; J.aux = 2; }
    } else if (kind == GP_RET_GATE) { tile_mn(L, 32, tm, tn); J.A = U; J.B = WM + (size_t)4096 * 1024; J.epi = EPI_MERGE; J.out = AR; }
    else if (kind == GP_RET_OUT) { tile_mn(L < 1024 ? L : 1024 + ((L - 1024) >> 2), 8, tm, tn); J.A = (const bf16_t*)AR; J.lda = 2048; J.B = WM + (size_t)8192 * 1024; J.ldb = 2048; J.K = 2048; J.epi = EPI_BF16; J.out = AR + 3 * SZ_U; }
    else if (kind == GP_DIFF_IN) {
      if (L < 1088) { tile_mn(L, 8, tm, tn); J.A = U; J.B = WM; J.epi = EPI_ROPE_DIFF_N; J.out = AR; }
      else if (L < 2176) { tile_mn(L - 1088, 8, tm, tn); J.A = U; J.B = WM + (size_t)1024 * 1024; J.epi = EPI_ROPE_DIFF_N; J.out = AR + SZ_U; }
      else { tile_mn(L - 2176, 136, tm, tn); J.A = WM + (size_t)2048 * 1024; J.B = U; J.epi = EPI_BF16; J.out = AR + 2 * SZ_U; J.ldc = T; J.aux = 1; }
    } else if (kind == GP_DIFF_OUT) { tile_mn(L < 1024 ? L : 1024 + ((L - 1024) >> 2), 8, tm, tn); J.A = (const bf16_t*)(AR + 5 * SZ_U); J.B = WM + (size_t)3072 * 1024; J.epi = EPI_BF16; J.out = AR + 3 * SZ_U; }
    else if (kind == GP_FFN_UP) { tile_mn(L, 44, tm, tn); J.A = U; J.B = WF; J.epi = EPI_ACT; J.out = AR + 6 * SZ_U; J.aux = layer; }
    else { tile_mn(L < 1024 ? L : 1024 + ((L - 1024) >> 2), 8, tm, tn); J.A = (const bf16_t*)(AR + 6 * SZ_U); J.lda = 2816; J.B = WF + (size_t)5632 * 1024; J.ldb = 2816; J.K = 2816; J.epi = EPI_BF16; J.out = AR; }
    if ((kind == GP_RET_OUT || kind == GP_DIFF_OUT || kind == GP_FFN_DOWN) && L >= 1024) {
      const int kp = (L - 1024) & 3, kq = J.K >> 2;
      J.A += kp * kq; J.B += kp * kq; J.K = kq; J.epi = EPI_F32; J.ldc = 1024;
      J.out = (float*)(AR + 4 * SZ_U) + (size_t)kp * 1024 * 1024 - (size_t)TL * 1024;
    }
    J.m0 = tm * 128; J.n0 = tn * 128;
    gemm_tile(P, J, lds, tid);
  }
}

DI void write_rt(const f32x16 (&accR)[2], char* lds, int w, int l31, int hi) {
#pragma unroll
  for (int td = 0; td < 2; ++td)
#pragma unroll
    for (int g = 0; g < 4; ++g) {
      const int d = 64 * w + 32 * td + 8 * g + 4 * hi, v = l31;
      u32x2 pk; pk.x = pk2(accR[td][4 * g], accR[td][4 * g + 1]); pk.y = pk2(accR[td][4 * g + 2], accR[td][4 * g + 3]);
      *(u32x2*)(lds + v * 512 + (((d >> 3) ^ (v & 15)) << 4) + (d & 7) * 2) = pk;
    }
}
DI int ret_r0(int cc, int dir, int b) { return cc < 2 ? TL + b * 256 + 128 * (dir ? 1 - cc : cc) : b * 4096 + 128 * (dir ? 33 - cc : cc - 2); }
DI void ret_phase(const Params& P, int l, char* lds, int wid_s) {
  const int tid = otid(), lane = tid & 63, w = tid >> 6, l31 = lane & 31, hi = lane >> 5, il = l >> 1;
  const char* q = P.ws + OFF_AR; const char* pd = P.ws + OFF_AR + SZ_U;
  const char* kT = P.ws + OFF_AR + 2 * SZ_U; const char* vT = P.ws + OFF_AR + 3 * SZ_U;
  for (int item = blockIdx.x; item < 512; item += gridDim.x) {
    const int dvs = item & 15, dir = (item >> 4) & 1, hh = (item >> 5) & 3, b = item >> 7;
    const float logit = (dir ? P.ret_db : P.ret_df)[il * 4 + hh];
    const float l2g = -log2f(1.f + expf(-logit));
    const float cdec = ex2(l2g * 128.f);
    const float gstep = ex2(dir ? l2g : -l2g);
    char* obuf = P.ws + OFF_AR + (dir ? 7 : 5) * SZ_U;
    float* ssq = (float*)(P.ws + OFF_SSQ) + (dir ? (size_t)T * 64 : 0);
    f32x16 accR[2];
#pragma unroll
    for (int a = 0; a < 2; ++a)
#pragma unroll
      for (int r = 0; r < 16; ++r) accR[a][r] = 0.f;
    __syncthreads();
    write_rt(accR, lds, w, l31, hi);
    __syncthreads();
    bf16x8 pa[8], bv[8], bq[16];
    {
      const int r0 = ret_r0(0, dir, b);
      const unsigned po = (unsigned)((((((r0 >> 5) + w) * 4 + hh) * 16) * 64) + lane) * 16u;
      const unsigned pf = (unsigned)((r0 + (dir * 4 + w) * 16 + hi) * 1024 + hh * 256 + l31 * 8) * 2u;
      const unsigned vo = (unsigned)((((hh * 16 + dvs) * 136 + (r0 >> 7)) * 8) * 64 + lane) * 16u;
#pragma unroll
      for (int s = 0; s < 8; ++s) { pa[s] = *(const bf16x8*)(pd + (pf + 4096u * s)); bv[s] = *(const bf16x8*)(vT + (vo + 1024u * s)); }
#pragma unroll
      for (int s = 0; s < 16; ++s) bq[s] = *(const bf16x8*)(q + (po + 1024u * s));
    }
    for (int cc = 0; cc < 34; ++cc) {
      float lg = l2g; int hiv = hi, l31v = l31; asm volatile("" : "+v"(lg), "+v"(hiv), "+v"(l31v));
      const int r0 = ret_r0(cc, dir, b);
      f32x16 accO, accQ;
#pragma unroll
      for (int r = 0; r < 16; ++r) { accO[r] = 0.f; accQ[r] = 0.f; }
#pragma unroll
      for (int s = 0; s < 8; ++s) accO = MFMA(pa[s], bv[s], accO);
#pragma unroll
      for (int s = 0; s < 16; ++s) { const bf16x8 br = *(const bf16x8*)(lds + l31v * 512 + (((2 * s + hiv) ^ (l31v & 15)) << 4)); accQ = MFMA(bq[s], br, accQ); }
#pragma unroll
      for (int r = 0; r < 16; ++r) {
        const int i2 = 32 * w + crow(r, hiv); const float e = dir ? (float)(128 - i2) : (float)(i2 + 1);
        const float o = accO[r] + ex2(lg * e) * accQ[r];
        const int row = r0 + i2;
        *(bf16_t*)(obuf + (unsigned)(row * 2048 + hh * 512 + dvs * 32 + l31v) * 2u) = f2bf(o);
        float sq = o * o;
        sq = dpp_xadd<0xB1>(sq); sq = dpp_xadd<0x4E>(sq); sq = dpp_xadd<0x141>(sq); sq = dpp_xadd<0x140>(sq);
        sq += __shfl_xor(sq, 16);
        if (l31v == 0) ssq[(row * 4 + hh) * 16 + dvs] = sq;
      }
      __builtin_amdgcn_sched_barrier(0);
      bf16x8 ak[2][8];
      if (cc < 33) {
        const unsigned kto = (unsigned)((((hh * 8 + 2 * w) * 136 + (r0 >> 7)) * 8) * 64 + l31v + 32 * hiv) * 16u;
#pragma unroll
        for (int td = 0; td < 2; ++td)
#pragma unroll
          for (int s = 0; s < 8; ++s) ak[td][s] = *(const bf16x8*)(kT + (kto + (unsigned)(td * 136 * 8 * 64 * 16) + 1024u * s));
      }
      if (cc < 33) {
#pragma unroll
        for (int a = 0; a < 2; ++a)
#pragma unroll
          for (int r = 0; r < 16; ++r) accR[a][r] *= cdec;
#pragma unroll
        for (int s = 0; s < 8; ++s) {
          float z[8];
          { const int j0 = 16 * s + 8 * hiv; z[0] = ex2(lg * (float)(dir ? j0 : 127 - j0));
#pragma unroll
            for (int e = 1; e < 8; ++e) z[e] = z[e - 1] * gstep; }
          const u32x4 raw = __builtin_bit_cast(u32x4, bv[s]);
          u32x4 sc;
          sc.x = pk2(bflo(raw.x) * z[0], bfhi(raw.x) * z[1]); sc.y = pk2(bflo(raw.y) * z[2], bfhi(raw.y) * z[3]);
          sc.z = pk2(bflo(raw.z) * z[4], bfhi(raw.z) * z[5]); sc.w = pk2(bflo(raw.w) * z[6], bfhi(raw.w) * z[7]);
          const bf16x8 bvs = __builtin_bit_cast(bf16x8, sc);
          accR[0] = MFMA(ak[0][s], bvs, accR[0]); accR[1] = MFMA(ak[1][s], bvs, accR[1]);
        }
        const int r1 = ret_r0(cc + 1, dir, b);
        const unsigned po = (unsigned)((((((r1 >> 5) + w) * 4 + hh) * 16) * 64) + l31v + 32 * hiv) * 16u;
        const unsigned pf = (unsigned)((r1 + (dir * 4 + w) * 16 + hiv) * 1024 + hh * 256 + l31v * 8) * 2u;
        const unsigned vo = (unsigned)((((hh * 16 + dvs) * 136 + (r1 >> 7)) * 8) * 64 + l31v + 32 * hiv) * 16u;
#pragma unroll
        for (int s = 0; s < 8; ++s) { pa[s] = *(const bf16x8*)(pd + (pf + 4096u * s)); bv[s] = *(const bf16x8*)(vT + (vo + 1024u * s)); }
#pragma unroll
        for (int s = 0; s < 16; ++s) bq[s] = *(const bf16x8*)(q + (po + 1024u * s));
        __builtin_amdgcn_sched_barrier(0);
        __syncthreads();
        write_rt(accR, lds, w, l31v, hiv);
        __syncthreads();
      }
    }
  }
}

DI void att_phase(const Params& P, int l, char* lds, int wid_s) {
  const int tid = otid(), lane = tid & 63, w = tid >> 6, l31 = lane & 31, hi = lane >> 5, il = l >> 1;
  const bf16_t* q = (const bf16_t*)(P.ws + OFF_AR); const bf16_t* k = (const bf16_t*)(P.ws + OFF_AR + SZ_U);
  const bf16_t* vT = (const bf16_t*)(P.ws + OFF_AR + 2 * SZ_U); bf16_t* att = (bf16_t*)(P.ws + OFF_AR + 5 * SZ_U);
  const float csc = 0.125f * 1.4426950408889634f;
  for (int item = blockIdx.x; item < (l == 3 ? 1024 : 1024 + 64); item += gridDim.x) {
    int b, hh, R0, nt, nlat;
    if (item < 1024) { b = item >> 8; hh = (item >> 5) & 7; R0 = b * 4096 + 128 * (item & 31); nt = 68; nlat = 64; }
    else { const int i2 = item - 1024; b = i2 >> 4; hh = (i2 >> 1) & 7; R0 = TL + b * 256 + 128 * (i2 & 1); nt = 4; nlat = 0; }
    const int qrow = R0 + 32 * w + l31;
    bf16x8 bq[2][4];
#pragma unroll
    for (int r2 = 0; r2 < 2; ++r2)
#pragma unroll
      for (int s = 0; s < 4; ++s) bq[r2][s] = *(const bf16x8*)(q + (size_t)qrow * 1024 + hh * 128 + 64 * r2 + 16 * s + 8 * hi);
    f32x16 oT[2][4];
#pragma unroll
    for (int r2 = 0; r2 < 2; ++r2)
#pragma unroll
      for (int a = 0; a < 4; ++a)
#pragma unroll
        for (int r = 0; r < 16; ++r) oT[r2][a][r] = 0.f;
    float mrun[2] = {-1e30f, -1e30f}, lsum[2] = {0.f, 0.f};
    auto keybase = [&](int t) { return t < nlat ? b * 4096 + 64 * t : TL + b * 256 + 64 * (t - nlat); };
    auto dma = [&](int t, int buf) {
      int t2 = tid; asm volatile("" : "+v"(t2));
      const int kch = (t2 & 15) ^ ((t2 >> 4) & 15), krow_l = t2 >> 4;
      const int vch = (t2 & 7) ^ ((t2 >> 4) & 7), vrow_l = t2 >> 3;
      const int kb = keybase(t);
      const unsigned ko = (unsigned)((kb + krow_l) * 1024 + hh * 128 + kch * 8) * 2u;
      const unsigned vo = (unsigned)((hh * 128 + vrow_l) * T + kb + vch * 8) * 2u;
      char* kd = lds + buf * 16384 + t2 * 16; char* vd = lds + 32768 + buf * 16384 + t2 * 16;
#pragma unroll
      for (int i = 0; i < 4; ++i) {
        GLDS((const char*)k + (ko + (unsigned)(i * 16 * 1024 * 2)), kd + i * 4096);
        GLDS((const char*)vT + (vo + (unsigned)(i * 32 * T * 2)), vd + i * 4096);
      }
    };
    __syncthreads();
    dma(0, 0);
    asm volatile("s_waitcnt vmcnt(0)" ::: "memory");
    __syncthreads();
    for (int t = 0; t < nt; ++t) {
      const char* kb_ = lds + (t & 1) * 16384; const char* vb_ = lds + 32768 + (t & 1) * 16384;
      if (t + 1 < nt) dma(t + 1, (t + 1) & 1);
#pragma unroll
      for (int r2 = 0; r2 < 2; ++r2) {
        int l31v = l31, hiv = hi; asm volatile("" : "+v"(l31v), "+v"(hiv));
        f32x16 st[2];
#pragma unroll
        for (int jt = 0; jt < 2; ++jt) {
#pragma unroll
          for (int r = 0; r < 16; ++r) st[jt][r] = 0.f;
          const int row = 32 * jt + l31v;
#pragma unroll
          for (int s = 0; s < 4; ++s) { const bf16x8 ak = *(const bf16x8*)(kb_ + row * 256 + (((8 * r2 + 2 * s + hiv) ^ (row & 15)) << 4)); st[jt] = MFMA(ak, bq[r2][s], st[jt]); }
        }
        float mx = st[0][0];
#pragma unroll
        for (int r = 1; r < 16; ++r) mx = fmaxf(mx, st[0][r]);
#pragma unroll
        for (int r = 0; r < 16; ++r) mx = fmaxf(mx, st[1][r]);
        mx = fmaxf(mx, __shfl_xor(mx, 32));
        const float mnew = fmaxf(mrun[r2], mx * csc), alpha = ex2(mrun[r2] - mnew);
        mrun[r2] = mnew;
        float ps = 0.f;
#pragma unroll
        for (int jt = 0; jt < 2; ++jt)
#pragma unroll
          for (int r = 0; r < 16; ++r) { const float p = ex2(st[jt][r] * csc - mnew); st[jt][r] = p; ps += p; }
        lsum[r2] = lsum[r2] * alpha + ps;
#pragma unroll
        for (int a = 0; a < 4; ++a)
#pragma unroll
          for (int r = 0; r < 16; ++r) oT[r2][a][r] *= alpha;
#pragma unroll
        for (int jt = 0; jt < 2; ++jt)
#pragma unroll
          for (int s2 = 0; s2 < 2; ++s2) {
            const bf16x8 pb = pack8(st[jt], s2);
            const int chunk = 4 * jt + 2 * s2 + hiv;
#pragma unroll
            for (int tv = 0; tv < 4; ++tv) {
              const int v = 32 * tv + l31v, sw = (v >> 1) & 7;
              const bf16x8 av = *(const bf16x8*)(vb_ + v * 128 + ((chunk ^ sw) << 4));
              oT[r2][tv] = MFMA(av, pb, oT[r2][tv]);
              if (tv & 1) __builtin_amdgcn_sched_barrier(0);
            }
          }
      }
      asm volatile("s_waitcnt vmcnt(0)" ::: "memory");
      __syncthreads();
    }
    lsum[0] += __shfl_xor(lsum[0], 32); lsum[1] += __shfl_xor(lsum[1], 32);
    int lv = l; asm volatile("" : "+s"(lv));
    const float lam_init = (lv == 1) ? 0.3555090676f : 0.5560582042f;
    float d1 = 0.f, d2 = 0.f;
    for (int e = 0; e < 64; ++e) { d1 += P.lq1[il * 64 + e] * P.lk1[il * 64 + e]; d2 += P.lq2[il * 64 + e] * P.lk2[il * 64 + e]; }
    const float lam = ex2(d1 * 1.4426950408889634f) - ex2(d2 * 1.4426950408889634f) + lam_init;
    const float inv0 = __builtin_amdgcn_rcpf(lsum[0]), inv1 = lam * __builtin_amdgcn_rcpf(lsum[1]);
    float ss = 0.f;
#pragma unroll
    for (int a = 0; a < 4; ++a)
#pragma unroll
      for (int r = 0; r < 16; ++r) { const float o = oT[0][a][r] * inv0 - oT[1][a][r] * inv1; oT[0][a][r] = o; ss += o * o; }
    ss += __shfl_xor(ss, 32);
    const float rstd = __builtin_amdgcn_rsqf(ss * (1.f / 128.f) + EPS) * (1.f - lam_init);
    const float* sg = P.subln + il * 128;
    int t3 = tid; asm volatile("" : "+v"(t3));
    const int qrow2 = R0 + 32 * (t3 >> 6) + (t3 & 31), hi3 = (t3 >> 5) & 1;
#pragma unroll
    for (int a = 0; a < 4; ++a)
#pragma unroll
      for (int g = 0; g < 4; ++g) {
        const int v = 32 * a + 8 * g + 4 * hi3;
        const f32x4 gg = *(const f32x4*)(sg + v);
        u32x2 pk; pk.x = pk2(oT[0][a][4 * g] * rstd * gg.x, oT[0][a][4 * g + 1] * rstd * gg.y); pk.y = pk2(oT[0][a][4 * g + 2] * rstd * gg.z, oT[0][a][4 * g + 3] * rstd * gg.w);
        *(u32x2*)(att + (size_t)qrow2 * 1024 + hh * 128 + v) = pk;
      }
  }
}

__global__ void __launch_bounds__(NTH, 2) fwd_kernel(Params P) {
  __shared__ __attribute__((aligned(16))) char lds[65536];
  cg::grid_group grid = cg::this_grid();
  int ph = 0;
  __shared__ unsigned xb_st[4];
  const int wid_s = __builtin_amdgcn_readfirstlane((int)threadIdx.x >> 6);
  if (wid_s == 0 && lane_id() < 4) xb_st[lane_id()] = 0u;
  __syncthreads();
  const XcdBarrier xb = xcd_barrier_post((unsigned*)(P.ws + OFF_BAR), (volatile LAS unsigned*)xb_st, wid_s);
  const bf16_t* ymix = (const bf16_t*)(P.ws + OFF_AR + 3 * SZ_U); const bf16_t* yffn = (const bf16_t*)(P.ws + OFF_AR);
#define PHASE_BEGIN if (ph >= P.lo && ph < P.hi) {
#define PHASE_END if (ph + 1 < P.hi) { if (P.lo < 0) grid.sync(); xcd_barrier(xb, wid_s); } } ++ph;
#ifndef PH_MASK
#define PH_MASK 0xffff
#endif
#define HAS(n) ((PH_MASK >> (n)) & 1)
#ifndef REP
#define REP 0
#endif
#define NREP(n) (((REP >> (n)) & 1) ? 2 : 1)
  PHASE_BEGIN
#if HAS(0)
    for (int rr = 0; rr < NREP(0); ++rr) mod_phase(P, lds, wid_s);
#endif
#if HAS(1)
    for (int rr = 0; rr < NREP(1); ++rr) { int base = 384; conv_mixer(P, 0, lds, base, wid_s); conv_ffn(P, 0, lds, base, wid_s); }
#endif
  PHASE_END
  for (int l = 0; l < 4; ++l) {
    const bool ret = (l & 1) == 0;
    PHASE_BEGIN
#if HAS(2)
      if (l == 0) pn_phase(P, -1, 0, 0, 0, true, nullptr, wid_s); else pn_phase(P, l - 1, 1, l, 0, false, yffn, wid_s);
#endif
#if HAS(1)
      if (l > 0) for (int rr = 0; rr < NREP(1); ++rr) { int base = 0; conv_ffn(P, l, lds, base, wid_s); }
#endif
    PHASE_END
    PHASE_BEGIN
#if HAS(3)
      for (int rr = 0; rr < NREP(3); ++rr) gemm_phase(P, ret ? GP_RET_IN : GP_DIFF_IN, lds, l, wid_s);
#endif
    PHASE_END
    if (ret) { PHASE_BEGIN
#if HAS(3)
      gemm_phase(P, GP_RET_S, lds, l, wid_s);
#endif
    PHASE_END }
    PHASE_BEGIN
#if HAS(4)
      if (ret) for (int rr = 0; rr < NREP(4); ++rr) ret_phase(P, l, lds, wid_s);
#endif
#if HAS(5)
      if (!ret) for (int rr = 0; rr < NREP(5); ++rr) att_phase(P, l, lds, wid_s);
#endif
    PHASE_END
    if (ret) { PHASE_BEGIN
#if HAS(3)
      for (int rr = 0; rr < NREP(3); ++rr) gemm_phase(P, GP_RET_GATE, lds, l, wid_s);
#endif
    PHASE_END }
    PHASE_BEGIN
#if HAS(3)
      for (int rr = 0; rr < NREP(3); ++rr) gemm_phase(P, ret ? GP_RET_OUT : GP_DIFF_OUT, lds, l, wid_s);
#endif
    PHASE_END
    PHASE_BEGIN
#if HAS(2)
      pn_phase(P, l, 0, l, 1, l == 0, ymix, wid_s);
#endif
#if HAS(1)
      if (l < 3) for (int rr = 0; rr < NREP(1); ++rr) { int base = 0; conv_mixer(P, l + 1, lds, base, wid_s); }
#endif
    PHASE_END
    PHASE_BEGIN
#if HAS(3)
      for (int rr = 0; rr < NREP(3); ++rr) gemm_phase(P, GP_FFN_UP, lds, l, wid_s);
#endif
    PHASE_END
    PHASE_BEGIN
#if HAS(6)
      for (int rr = 0; rr < NREP(6); ++rr) act_phase(P, l, wid_s);
#endif
    PHASE_END
    PHASE_BEGIN
#if HAS(3)
      for (int rr = 0; rr < NREP(3); ++rr) gemm_phase(P, GP_FFN_DOWN, lds, l, wid_s);
#endif
    PHASE_END
  }
  PHASE_BEGIN
#if HAS(2)
    pn_phase(P, 3, 1, -1, 0, false, yffn, wid_s);
#endif
  PHASE_END
}
constexpr int N_PHASES = 1 + 10 + 8 + 10 + 8 + 1;
#ifdef STOP_AT
__global__ void dump_kernel(const unsigned short* ws, float* out, size_t nws16) {
  size_t i = (size_t)blockIdx.x * 256 + threadIdx.x;
  unsigned acc = 0;
  for (size_t j = i; j < nws16; j += (size_t)TL * 1024) acc = acc * 31u + ws[j];
  out[i] = (float)(acc & 0xFFFFu) * (1.f / 65536.f);
}
#endif

extern "C" void kernel_launch(void* const* d_in, const int* in_sizes, int n_in, void* d_out, int out_size, void* d_ws, size_t ws_size, hipStream_t stream) {
  static int grid_blocks = 0;
  if (!grid_blocks) {
    int dev = 0, cus = 0, per_cu = 0;
    hipGetDevice(&dev);
    hipDeviceGetAttribute(&cus, hipDeviceAttributeMultiprocessorCount, dev);
    hipOccupancyMaxActiveBlocksPerMultiprocessor(&per_cu, fwd_kernel, NTH, 0);
    if (per_cu > 2) per_cu = 2;
    if (per_cu < 1) per_cu = 1;
    grid_blocks = cus * per_cu;
  }
  if (ws_size < WS_NEED) fprintf(stderr, "workspace too small: %zu < %zu\n", ws_size, (size_t)WS_NEED);
  Params p{};
  const float** f = (const float**)&p;
  for (int i = 0; i < 22; ++i) f[i] = (const float*)d_in[i];
  p.out = (float*)d_out; p.ws = (char*)d_ws;
#if MULTI_LAUNCH
#ifdef STOP_AT
  for (int ph = 0; ph < STOP_AT; ++ph) { p.lo = ph; p.hi = ph + 1; hipLaunchKernelGGL(fwd_kernel, dim3(grid_blocks), dim3(NTH), 0, stream, p); }
  hipLaunchKernelGGL(dump_kernel, dim3(TL * 1024 / 256), dim3(256), 0, stream, (const unsigned short*)d_ws, (float*)d_out, (size_t)WS_NEED / 2);
#else
  for (int ph = 0; ph < N_PHASES; ++ph) { p.lo = ph; p.hi = ph + 1; hipLaunchKernelGGL(fwd_kernel, dim3(grid_blocks), dim3(NTH), 0, stream, p); }
#endif
#else
  p.lo = 0; p.hi = N_PHASES;
  hipMemsetAsync((char*)d_ws + OFF_BAR, 0, 16384, stream);
  void* args[] = {&p};
  hipError_t e = hipLaunchCooperativeKernel((void*)fwd_kernel, dim3(grid_blocks), dim3(NTH), args, 0, stream);
  if (e != hipSuccess) fprintf(stderr, "cooperative launch failed: %s (grid %d)\n", hipGetErrorString(e), grid_blocks);
#endif
}
```

```cpp
#include <hip/hip_runtime.h>
#include <hip/hip_cooperative_groups.h>
#include <cstdio>
#include <cstdint>
namespace cg = cooperative_groups;

#ifndef MULTI_LAUNCH
#define MULTI_LAUNCH 0
#endif

typedef unsigned short bf16_t;
typedef short bf16x8 __attribute__((ext_vector_type(8)));
typedef short s16x4 __attribute__((ext_vector_type(4)));
typedef float f32x16 __attribute__((ext_vector_type(16)));
typedef float f32x4 __attribute__((ext_vector_type(4)));
typedef float f32x2 __attribute__((ext_vector_type(2)));
typedef unsigned u32x4 __attribute__((ext_vector_type(4)));
typedef unsigned u32x2 __attribute__((ext_vector_type(2)));
typedef __bf16 bf2_t __attribute__((ext_vector_type(2)));

#define DI __device__ __forceinline__
typedef __attribute__((address_space(3))) unsigned lds_u32_t;
#define GLDS(gp, lp) __builtin_amdgcn_global_load_lds((const unsigned*)(gp), (lds_u32_t*)(lp), 16, 0, 0)
#define MFMA(a, b, c) __builtin_amdgcn_mfma_f32_32x32x16_bf16((a), (b), (c), 0, 0, 0)

constexpr int T = 17408, TL = 16384, DM = 1024, NTH = 256;
constexpr float EPS = 1e-6f;
constexpr size_t SZ_U = (size_t)T * 1024 * 2;
constexpr size_t OFF_MOD = 0;
constexpr size_t OFF_TABR = OFF_MOD + 4 * 5 * 6144 * 4;
constexpr size_t OFF_TABD = OFF_TABR + 64 * 64 * 8;
constexpr size_t OFF_SSQ = OFF_TABD + 64 * 16 * 8;
constexpr size_t OFF_HC = OFF_SSQ + (size_t)T * 64 * 4 * 2;
constexpr size_t OFF_U = OFF_HC + 1024 * 1024 * 4;
constexpr size_t OFF_WM = OFF_U + SZ_U;
constexpr size_t OFF_WF = OFF_WM + (size_t)8192 * 1024 * 2 + (size_t)1024 * 2048 * 2;
constexpr size_t OFF_AR = OFF_WF + (size_t)5632 * 1024 * 2 + (size_t)1024 * 2816 * 2;
constexpr size_t OFF_BAR = OFF_AR + 9 * SZ_U;
constexpr size_t WS_NEED = OFF_BAR + 16384;

struct Params {
  const float *x, *c, *ctx, *c_ctx, *ada_w, *ada_b, *norm_g, *ret_w_in, *ret_w_out, *ret_df, *ret_db;
  const float *diff_w_in, *diff_w_out, *lq1, *lk1, *lq2, *lk2, *subln, *ffn_up, *ffn_cw, *ffn_cb, *ffn_down;
  float* out; char* ws; int lo, hi;
};

DI unsigned pk2(float lo, float hi) { f32x2 v = {lo, hi}; bf2_t b = __builtin_convertvector(v, bf2_t); return __builtin_bit_cast(unsigned, b); }
DI bf16_t f2bf(float x) { return (bf16_t)(pk2(x, 0.f) & 0xffffu); }
DI float bflo(unsigned u) { return __uint_as_float(u << 16); }
DI float bfhi(unsigned u) { return __uint_as_float(u & 0xffff0000u); }
DI float bf2f(bf16_t x) { return __uint_as_float((unsigned)x << 16); }
DI int crow(int reg, int h) { return (reg & 3) + 8 * (reg >> 2) + 4 * h; }
DI float ex2(float x) { return __builtin_amdgcn_exp2f(x); }
DI float wsum(float v) { for (int m = 32; m >= 1; m >>= 1) v += __shfl_xor(v, m); return v; }
DI float siluf(float x) { return x * __builtin_amdgcn_rcpf(1.f + __expf(-x)); }
DI bf16x8 pack8(const f32x16& x, int s) {
  u32x4 p; p.x = pk2(x[8 * s], x[8 * s + 1]); p.y = pk2(x[8 * s + 2], x[8 * s + 3]); p.z = pk2(x[8 * s + 4], x[8 * s + 5]); p.w = pk2(x[8 * s + 6], x[8 * s + 7]);
  return __builtin_bit_cast(bf16x8, p);
}
DI int lane_id() { return (int)__builtin_amdgcn_mbcnt_hi(~0u, __builtin_amdgcn_mbcnt_lo(~0u, 0u)); }
DI int otid_w(int wid_s) { int t = (wid_s << 6) | lane_id(); asm volatile("" : "+v"(t)); return t; }
#define otid() otid_w(wid_s)
DI f32x2 rope_cs(int pos, int fi, float cexp) {
  const float ang = (float)pos * ex2(-(float)fi * cexp);
  const float rev = ang * 0.15915494309189535f;
  const float fr = rev - rintf(rev);
  f32x2 cs; cs.x = __builtin_amdgcn_cosf(fr); cs.y = __builtin_amdgcn_sinf(fr); return cs;
}
#define XB_TMO      128
#define XB_XCNT(j)  (256  + 64 * (j))
#define XB_XSUB(j)  (1280 + 64 * (j))
#define XB_XGEN(j)  (2304 + 64 * (j))
#define XB_TOP      3328
#define XB_TOPGEN   3392
#define XB_SPIN_CAP (1u << 22)
#define LAS __attribute__((address_space(3)))
DI unsigned xb_ld(unsigned* p) { return __hip_atomic_load(p, __ATOMIC_RELAXED, __HIP_MEMORY_SCOPE_AGENT); }
DI unsigned xb_add(unsigned* p, unsigned v) { return __hip_atomic_fetch_add(p, v, __ATOMIC_RELAXED, __HIP_MEMORY_SCOPE_AGENT); }
DI unsigned xb_xcc_id() { return (unsigned)__builtin_amdgcn_s_getreg((3 << 11) | 20) & 0xFu; }
#define XB_SPIN(cond, bar) do { unsigned _sp = 0; while (cond) { __builtin_amdgcn_s_sleep(1); \
    if ((++_sp & 255u) == 0u) { if (xb_ld(&(bar)[XB_TMO])) break; if (_sp > XB_SPIN_CAP) { atomicAdd(&(bar)[XB_TMO], 1u); break; } } } } while (0)
struct XcdBarrier { unsigned* bar; unsigned x; volatile LAS unsigned* st; };
DI XcdBarrier xcd_barrier_post(unsigned* bar, volatile LAS unsigned* st, int wid_s) {
  XcdBarrier b; b.bar = bar; b.x = xb_xcc_id(); b.st = st;
  if (wid_s == 0 && lane_id() == 0) (void)xb_add(&bar[XB_XCNT(b.x)], 1u);
  return b;
}
DI void xcd_barrier_complete(unsigned* bar, unsigned x, unsigned& nloc, unsigned& nx) {
  const unsigned G = gridDim.x;
  unsigned sum, cnt, mine, sp = 0u;
  for (;;) {
    sum = 0u; cnt = 0u; mine = 0u;
#pragma unroll
    for (unsigned j = 0; j < 16; ++j) { const unsigned c = xb_ld(&bar[XB_XCNT(j)]); sum += c; cnt += (c > 0u) ? 1u : 0u; mine = (j == x) ? c : mine; }
    if (sum == G) break;
    __builtin_amdgcn_s_sleep(1);
    if ((++sp & 255u) == 0u) { if (xb_ld(&bar[XB_TMO])) break; if (sp > XB_SPIN_CAP) { atomicAdd(&bar[XB_TMO], 1u); break; } }
  }
  nloc = mine > 0u ? mine : 1u; nx = cnt > 0u ? cnt : 1u;
}
DI void xcd_barrier(const XcdBarrier& b, int wid_s) {
  asm volatile("s_waitcnt vmcnt(0)" ::: "memory");
  __syncthreads();
  if (wid_s == 0 && lane_id() == 0) {
    unsigned* bar = b.bar;
    __builtin_amdgcn_s_waitcnt(0);
    unsigned nloc = b.st[0], nx = b.st[1];
    if (nloc == 0u) { xcd_barrier_complete(bar, b.x, nloc, nx); b.st[0] = nloc; b.st[1] = nx; }
    const unsigned old = xb_add(&bar[XB_XSUB(b.x)], 1u);
    const unsigned gen = old / nloc;
    if (old + 1u == (gen + 1u) * nloc) {
      __builtin_amdgcn_fence(__ATOMIC_RELEASE, "agent");
      asm volatile("s_waitcnt vmcnt(0)" ::: "memory");
      const unsigned og = xb_add(&bar[XB_TOP], 1u);
      const unsigned tg = og / nx;
      if (og + 1u == (tg + 1u) * nx) xb_add(&bar[XB_TOPGEN], 1u);
      else XB_SPIN(xb_ld(&bar[XB_TOPGEN]) == tg, bar);
      __builtin_amdgcn_fence(__ATOMIC_ACQUIRE, "agent");
      xb_add(&bar[XB_XGEN(b.x)], 1u);
      asm volatile("s_waitcnt vmcnt(0)" ::: "memory");
    } else {
      XB_SPIN(xb_ld(&bar[XB_XGEN(b.x)]) == gen, bar);
      __builtin_amdgcn_fence(__ATOMIC_ACQUIRE, "agent");
      asm volatile("s_waitcnt vmcnt(0)" ::: "memory");
    }
  }
  __syncthreads();
}
template <int CTRL> DI float dpp_xadd(float x) { return x + __int_as_float(__builtin_amdgcn_update_dpp(0, __float_as_int(x), CTRL, 0xF, 0xF, true)); }
DI int rowbsel(int row) { return row < TL ? (row >> 12) : 4; }

DI int srccol(int g, int mode) {
  if (mode == 1) {
    if (g < 2048) return (g & ~127) + 32 * ((g >> 6) & 1) + (g & 31) + 64 * ((g >> 5) & 1);
    if (g < 4096) return g;
    int gp = g - 4096; return 4096 + 2048 * ((gp >> 5) & 1) + 32 * (gp >> 6) + (gp & 31);
  }
  if (mode == 2) {
    if (g < 2048) { int c = g & 31; return (g & ~63) + (c < 16 ? c : c + 16) + 16 * ((g >> 5) & 1); }
    return g;
  }
  if (mode == 3) return 64 * (g >> 7) + (g & 63) + 2816 * ((g >> 6) & 1);
  return g;
}
DI void conv_range(const float* __restrict__ src, int nsrc, bf16_t* __restrict__ dst, int K, int nrows, int mode, char* lds, int& base, int wid_s) {
  float (*tile)[65] = (float (*)[65])lds;
  const int tid = otid(), nkb = K >> 6, nitems = (nrows >> 6) * nkb, G = gridDim.x;
  int it = (int)((blockIdx.x + G - (base % G)) % G);
  float r[16];
  if (it < nitems) {
    const int g0 = (it / nkb) * 64, k0 = (it % nkb) * 64;
#pragma unroll
    for (int i = 0; i < 16; ++i) { int e = tid + 256 * i, kk = e >> 6, gg = e & 63; r[i] = src[(size_t)(k0 + kk) * nsrc + srccol(g0 + gg, mode)]; }
  }
  for (; it < nitems; it += G) {
    const int g0 = (it / nkb) * 64, k0 = (it % nkb) * 64;
#pragma unroll
    for (int i = 0; i < 16; ++i) { int e = tid + 256 * i, kk = e >> 6, gg = e & 63; tile[kk][gg] = r[i]; }
    __syncthreads();
    if (it + G < nitems) {
      const int g1 = ((it + G) / nkb) * 64, k1 = ((it + G) % nkb) * 64;
#pragma unroll
      for (int i = 0; i < 16; ++i) { int e = tid + 256 * i, kk = e >> 6, gg = e & 63; r[i] = src[(size_t)(k1 + kk) * nsrc + srccol(g1 + gg, mode)]; }
    }
    const int gg = tid >> 2, kq = (tid & 3) * 16;
    u32x4 w0, w1;
    w0.x = pk2(tile[kq + 0][gg], tile[kq + 1][gg]); w0.y = pk2(tile[kq + 2][gg], tile[kq + 3][gg]); w0.z = pk2(tile[kq + 4][gg], tile[kq + 5][gg]); w0.w = pk2(tile[kq + 6][gg], tile[kq + 7][gg]);
    w1.x = pk2(tile[kq + 8][gg], tile[kq + 9][gg]); w1.y = pk2(tile[kq + 10][gg], tile[kq + 11][gg]); w1.z = pk2(tile[kq + 12][gg], tile[kq + 13][gg]); w1.w = pk2(tile[kq + 14][gg], tile[kq + 15][gg]);
    bf16_t* d = dst + (size_t)(g0 + gg) * K + k0 + kq;
    *(u32x4*)d = w0; *(u32x4*)(d + 8) = w1;
    __syncthreads();
  }
  base += nitems;
}
DI void conv_mixer(const Params& P, int l, char* lds, int& base, int wid_s) {
  bf16_t* WM = (bf16_t*)(P.ws + OFF_WM); const int i = l >> 1;
  if ((l & 1) == 0) {
    conv_range(P.ret_w_in + (size_t)i * 1024 * 8192, 8192, WM, 1024, 8192, 1, lds, base, wid_s);
    conv_range(P.ret_w_out + (size_t)i * 2048 * 1024, 1024, WM + (size_t)8192 * 1024, 2048, 1024, 0, lds, base, wid_s);
  } else {
    conv_range(P.diff_w_in + (size_t)i * 1024 * 3072, 3072, WM, 1024, 3072, 2, lds, base, wid_s);
    conv_range(P.diff_w_out + (size_t)i * 1024 * 1024, 1024, WM + (size_t)3072 * 1024, 1024, 1024, 0, lds, base, wid_s);
  }
}
DI void conv_ffn(const Params& P, int l, char* lds, int& base, int wid_s) {
  bf16_t* WF = (bf16_t*)(P.ws + OFF_WF);
  conv_range(P.ffn_up + (size_t)l * 1024 * 5632, 5632, WF, 1024, 5632, 3, lds, base, wid_s);
  conv_range(P.ffn_down + (size_t)l * 2816 * 1024, 1024, WF + (size_t)5632 * 1024, 2816, 1024, 0, lds, base, wid_s);
}

DI void mod_phase(const Params& P, char* lds, int wid_s) {
  const int tid = otid();
  float* sc = (float*)lds; float* red = (float*)(lds + 20480);
  float* mod = (float*)(P.ws + OFF_MOD);
  for (int e = tid; e < 5120; e += NTH) { int bs = e >> 10, k = e & 1023; float v = bs < 4 ? P.c[bs * 1024 + k] : P.c_ctx[k]; sc[e] = v / (1.f + __expf(-v)); }
  __syncthreads();
  for (int item = blockIdx.x; item < 384; item += gridDim.x) {
    const int l = item / 96, cgp = item % 96, kq = tid >> 6, cl = tid & 63, col = cgp * 64 + cl;
    float a0 = 0, a1 = 0, a2 = 0, a3 = 0, a4 = 0;
    const float* w = P.ada_w + ((size_t)l * 1024 + kq * 256) * 6144 + col;
#pragma unroll 8
    for (int k = 0; k < 256; ++k) { float wv = w[(size_t)k * 6144]; int kk = kq * 256 + k; a0 += sc[kk] * wv; a1 += sc[1024 + kk] * wv; a2 += sc[2048 + kk] * wv; a3 += sc[3072 + kk] * wv; a4 += sc[4096 + kk] * wv; }
    red[(kq * 5 + 0) * 64 + cl] = a0; red[(kq * 5 + 1) * 64 + cl] = a1; red[(kq * 5 + 2) * 64 + cl] = a2; red[(kq * 5 + 3) * 64 + cl] = a3; red[(kq * 5 + 4) * 64 + cl] = a4;
    __syncthreads();
    for (int e = tid; e < 320; e += NTH) { int bs = e >> 6, c2 = e & 63; float s = red[(0 * 5 + bs) * 64 + c2] + red[(1 * 5 + bs) * 64 + c2] + red[(2 * 5 + bs) * 64 + c2] + red[(3 * 5 + bs) * 64 + c2];
      mod[(size_t)(l * 5 + bs) * 6144 + cgp * 64 + c2] = s + P.ada_b[l * 6144 + cgp * 64 + c2]; }
    __syncthreads();
  }
}

DI void pn_phase(const Params& P, int l_res, int which_res, int l_pre, int which_pre, bool h_from_input, const bf16_t* ybuf, int wid_s) {
  const int tid0 = otid(); const int lane = tid0 & 63, w = tid0 >> 6;
  const float* mod = (const float*)(P.ws + OFF_MOD);
  float* hc = (float*)(P.ws + OFF_HC); bf16_t* u = (bf16_t*)(P.ws + OFF_U);
  const int nrows = (l_pre < 0 || (l_res == 3 && which_res == 0)) ? TL : T;
  const int nw = gridDim.x * 4;
  for (int row0 = blockIdx.x * 4 + w; row0 < nrows; row0 += 2 * nw) {
    int rows[2] = {row0, row0 + nw};
    const bool has1 = rows[1] < nrows; if (!has1) rows[1] = row0;
    const float* hin[2]; float* hout[2]; int bs[2];
    f32x4 hv[2][4], yv[2][4];
#pragma unroll
    for (int k = 0; k < 2; ++k) {
      const int row = rows[k]; bs[k] = rowbsel(row);
      hin[k] = h_from_input ? (row < TL ? P.x + (size_t)row * 1024 : P.ctx + (size_t)(row - TL) * 1024)
                            : (row < TL ? P.out + (size_t)row * 1024 : hc + (size_t)(row - TL) * 1024);
      hout[k] = row < TL ? P.out + (size_t)row * 1024 : hc + (size_t)(row - TL) * 1024;
#pragma unroll
      for (int i = 0; i < 4; ++i) hv[k][i] = *(const f32x4*)(hin[k] + lane * 4 + 256 * i);
      if (l_res >= 0) {
#pragma unroll
        for (int i = 0; i < 4; ++i) {
          if (row < TL) { const u32x2 yr = *(const u32x2*)(ybuf + (size_t)row * 1024 + lane * 4 + 256 * i); yv[k][i] = (f32x4){bflo(yr.x), bfhi(yr.x), bflo(yr.y), bfhi(yr.y)}; }
          else {
            const float* yp = (const float*)(P.ws + OFF_AR + 4 * SZ_U) + (size_t)(row - TL) * 1024 + lane * 4 + 256 * i;
            yv[k][i] = (*(const f32x4*)yp + *(const f32x4*)(yp + 1024 * 1024)) + (*(const f32x4*)(yp + 2 * 1024 * 1024) + *(const f32x4*)(yp + 3 * 1024 * 1024));
          }
        }
      }
    }
#pragma unroll
    for (int k = 0; k < 2; ++k) {
      if (k == 1 && !has1) break;
      const int row = rows[k];
      if (l_res >= 0) {
        float ss = 0.f;
#pragma unroll
        for (int i = 0; i < 4; ++i) ss += yv[k][i].x * yv[k][i].x + yv[k][i].y * yv[k][i].y + yv[k][i].z * yv[k][i].z + yv[k][i].w * yv[k][i].w;
        ss = wsum(ss); const float rstd = rsqrtf(ss * (1.f / 1024.f) + EPS);
        const float* gate = mod + (size_t)(l_res * 5 + bs[k]) * 6144 + (which_res ? 5 : 2) * 1024;
        const float* gp = P.norm_g + (size_t)(l_res * 4 + (which_res ? 3 : 1)) * 1024;
#pragma unroll
        for (int i = 0; i < 4; ++i) { f32x4 gt = *(const f32x4*)(gate + lane * 4 + 256 * i), gg = *(const f32x4*)(gp + lane * 4 + 256 * i); hv[k][i] += gt * (yv[k][i] * rstd * gg); *(f32x4*)(hout[k] + lane * 4 + 256 * i) = hv[k][i]; }
      }
      if (l_pre >= 0) {
        float ss = 0.f;
#pragma unroll
        for (int i = 0; i < 4; ++i) ss += hv[k][i].x * hv[k][i].x + hv[k][i].y * hv[k][i].y + hv[k][i].z * hv[k][i].z + hv[k][i].w * hv[k][i].w;
        ss = wsum(ss); const float rstd = rsqrtf(ss * (1.f / 1024.f) + EPS);
        const float* g = P.norm_g + (size_t)(l_pre * 4 + (which_pre ? 2 : 0)) * 1024;
        const float* sh = mod + (size_t)(l_pre * 5 + bs[k]) * 6144 + (which_pre ? 3 : 0) * 1024;
        const float* scv = mod + (size_t)(l_pre * 5 + bs[k]) * 6144 + (which_pre ? 4 : 1) * 1024;
#pragma unroll
        for (int i = 0; i < 4; ++i) {
          f32x4 gg = *(const f32x4*)(g + lane * 4 + 256 * i), s1 = *(const f32x4*)(sh + lane * 4 + 256 * i), s2 = *(const f32x4*)(scv + lane * 4 + 256 * i);
          f32x4 o = (hv[k][i] * rstd * gg) * (s2 + 1.f) + s1;
          u32x2 pk; pk.x = pk2(o.x, o.y); pk.y = pk2(o.z, o.w);
          *(u32x2*)(u + (size_t)row * 1024 + lane * 4 + 256 * i) = pk;
        }
      }
    }
  }
}

DI void act_phase(const Params& P, int l, int wid_s) {
  const bf16_t* __restrict__ vg = (const bf16_t*)(P.ws + OFF_AR); bf16_t* __restrict__ a = (bf16_t*)(P.ws + OFF_AR + 6 * SZ_U);
  const float* cw = P.ffn_cw + (size_t)l * 3 * 2816; const float* cb = P.ffn_cb + (size_t)l * 2816;
  const int tid = otid();
  for (int item = blockIdx.x; item < 272 * 352 / 256; item += gridDim.x) {
    const int u = item * 256 + tid; const int br = u / 352, ch = u - br * 352;
    const int r = (br >> 1) * 128 + (br & 1) * 127;
    const int p = r < TL ? (r & 4095) : ((r - TL) & 255); const int slen = r < TL ? 4096 : 256;
    const int f0 = ch * 8;
    const bf16_t* gp = vg + (size_t)r * 5632 + 2816 + f0;
    u32x4 g0 = {0, 0, 0, 0}, g2 = {0, 0, 0, 0};
    if (p != 0) g0 = *(const u32x4*)(gp - 5632);
    if (p + 1 < slen) g2 = *(const u32x4*)(gp + 5632);
    const u32x4 g1 = *(const u32x4*)gp, vv = *(const u32x4*)(vg + (size_t)r * 5632 + f0);
    float o[8];
#pragma unroll
    for (int qd = 0; qd < 4; ++qd) {
      const float x0 = cw[f0 + 2 * qd] * bflo(g0[qd]) + cw[2816 + f0 + 2 * qd] * bflo(g1[qd]) + cw[5632 + f0 + 2 * qd] * bflo(g2[qd]) + cb[f0 + 2 * qd];
      const float x1 = cw[f0 + 2 * qd + 1] * bfhi(g0[qd]) + cw[2816 + f0 + 2 * qd + 1] * bfhi(g1[qd]) + cw[5632 + f0 + 2 * qd + 1] * bfhi(g2[qd]) + cb[f0 + 2 * qd + 1];
      o[2 * qd] = siluf(x0) * bflo(vv[qd]); o[2 * qd + 1] = siluf(x1) * bfhi(vv[qd]);
    }
    u32x4 ov; ov.x = pk2(o[0], o[1]); ov.y = pk2(o[2], o[3]); ov.z = pk2(o[4], o[5]); ov.w = pk2(o[6], o[7]);
    *(u32x4*)(a + (size_t)r * 2816 + f0) = ov;
  }
}

enum { EPI_F32 = 0, EPI_BF16 = 1, EPI_ROPE_RET_N = 2, EPI_ROPE_RET_T = 3, EPI_ROPE_DIFF_N = 4, EPI_MERGE = 5, EPI_SMASK = 6, EPI_ACT = 7 };
struct Job { const bf16_t* A; const bf16_t* B; int lda, ldb, K, m0, n0, epi, ldc, aux, afrag; void* out; float scale; };

DI void gemm_tile(const Params& P, const Job& J, char* lds, int tid) {
  const int lane = tid & 63, w = tid >> 6, wm = w >> 1, wn = w & 1, l31 = lane & 31, hi = lane >> 5;
  f32x16 acc[2][2];
#pragma unroll
  for (int a = 0; a < 2; ++a)
#pragma unroll
    for (int b = 0; b < 2; ++b)
#pragma unroll
      for (int r = 0; r < 16; ++r) acc[a][b][r] = 0.f;
  const int lrow = tid >> 3, lkc = (tid & 7) ^ ((tid >> 4) & 7);
  const bf16_t* ga = J.afrag ? J.A + ((((size_t)(J.m0 >> 5) * 4 + (J.afrag - 1)) * 16 + (lkc >> 1)) * 64 + (lkc & 1) * 32 + lrow) * 8
                             : J.A + (size_t)(J.m0 + lrow) * J.lda + lkc * 8;
  const bf16_t* gb = J.B + (size_t)(J.n0 + lrow) * J.ldb + lkc * 8;
  const size_t sa = J.afrag ? (size_t)32768 : (size_t)32 * J.lda, sb = (size_t)32 * J.ldb;
  const size_t ksa = J.afrag ? 2048 : 64;
  const int swz = (lane >> 1) & 7;
  const int aoff = (64 * wm + l31) * 128, boff = 16384 + (64 * wn + l31) * 128;
  const int nk = J.K >> 6;
  char* wbase = lds + tid * 16;
#pragma unroll
  for (int i = 0; i < 4; ++i) { GLDS(ga + i * sa, wbase + i * 4096); GLDS(gb + i * sb, wbase + 16384 + i * 4096); }
  asm volatile("s_waitcnt vmcnt(0)" ::: "memory");
  __syncthreads();
  for (int kt = 0; kt < nk; ++kt) {
    const char* cur = lds + (kt & 1) * 32768; char* nxt = wbase + ((kt + 1) & 1) * 32768;
    if (kt + 1 < nk) {
#pragma unroll
      for (int i = 0; i < 4; ++i) { GLDS(ga + (size_t)(kt + 1) * ksa + i * sa, nxt + i * 4096); GLDS(gb + (size_t)(kt + 1) * 64 + i * sb, nxt + 16384 + i * 4096); }
    }
    bf16x8 fa[2][2], fb[2][2];
    { const int ko = ((0 + hi) ^ swz) << 4;
      fa[0][0] = *(const bf16x8*)(cur + aoff + ko); fa[0][1] = *(const bf16x8*)(cur + aoff + 4096 + ko);
      fb[0][0] = *(const bf16x8*)(cur + boff + ko); fb[0][1] = *(const bf16x8*)(cur + boff + 4096 + ko); }
#pragma unroll
    for (int s = 0; s < 4; ++s) {
      const int c = s & 1, n = c ^ 1;
      if (s < 3) {
        const int ko = ((2 * (s + 1) + hi) ^ swz) << 4;
        fa[n][0] = *(const bf16x8*)(cur + aoff + ko); fa[n][1] = *(const bf16x8*)(cur + aoff + 4096 + ko);
        fb[n][0] = *(const bf16x8*)(cur + boff + ko); fb[n][1] = *(const bf16x8*)(cur + boff + 4096 + ko);
      }
      acc[0][0] = MFMA(fa[c][0], fb[c][0], acc[0][0]); acc[0][1] = MFMA(fa[c][0], fb[c][1], acc[0][1]);
      acc[1][0] = MFMA(fa[c][1], fb[c][0], acc[1][0]); acc[1][1] = MFMA(fa[c][1], fb[c][1], acc[1][1]);
      __builtin_amdgcn_sched_barrier(0);
    }
    asm volatile("s_waitcnt vmcnt(0)" ::: "memory");
    __syncthreads();
  }
  int l31e = l31, hie = hi; asm volatile("" : "+v"(l31e), "+v"(hie));
  const int m0w = J.m0 + 64 * wm, n0w = J.n0 + 64 * wn;
  if (J.epi == EPI_F32) {
    float* o = (float*)J.out;
#pragma unroll
    for (int tm = 0; tm < 2; ++tm)
#pragma unroll
      for (int tn = 0; tn < 2; ++tn)
#pragma unroll
        for (int r = 0; r < 16; ++r) o[(size_t)(m0w + 32 * tm + crow(r, hie)) * J.ldc + n0w + 32 * tn + l31e] = acc[tm][tn][r];
    return;
  }
  constexpr int IST = 272;
  char* img = lds;
  bf16_t* obase; size_t oldc; int ocols = 128, ist = IST;
  if (J.epi == EPI_BF16) {
#pragma unroll
    for (int tm = 0; tm < 2; ++tm)
#pragma unroll
      for (int tn = 0; tn < 2; ++tn)
#pragma unroll
        for (int r = 0; r < 16; ++r) {
          int cl = 64 * wn + 32 * tn + l31e;
          if (J.aux & 1) cl = (cl & ~12) | ((cl & 4) << 1) | ((cl & 8) >> 1);
          *(bf16_t*)(img + (64 * wm + 32 * tm + crow(r, hie)) * IST + cl * 2) = f2bf(acc[tm][tn][r]);
        }
    obase = (bf16_t*)J.out + (size_t)J.m0 * J.ldc + J.n0; oldc = J.ldc;
  } else if (J.epi == EPI_ROPE_RET_N) {
    const int g128 = n0w >> 7, fi = 32 * wn + l31e;
#pragma unroll
    for (int tm = 0; tm < 2; ++tm)
#pragma unroll
      for (int r = 0; r < 16; ++r) {
        const int rl = 64 * wm + 32 * tm + crow(r, hie), row = J.m0 + rl;
        float x1 = acc[tm][0][r], x2 = acc[tm][1][r];
        if (row < TL) { const int pos = (g128 & 1) ? (row & 63) : ((row >> 6) & 63); const f32x2 cs = rope_cs(pos, fi, 13.287712379549449f / 64.f); const float y1 = x1 * cs.x - x2 * cs.y, y2 = x1 * cs.y + x2 * cs.x; x1 = y1; x2 = y2; }
        *(bf16_t*)(img + rl * IST + fi * 2) = f2bf(x1 * J.scale); *(bf16_t*)(img + rl * IST + (fi + 64) * 2) = f2bf(x2 * J.scale);
      }
    obase = (bf16_t*)J.out + (size_t)J.m0 * 1024 + J.n0; oldc = 1024;
  } else if (J.epi == EPI_ROPE_RET_T) {
    const int g128 = m0w >> 7;
#pragma unroll
    for (int tn = 0; tn < 2; ++tn) {
      const int cl = 64 * wn + 32 * tn + l31e, tok = J.n0 + cl; const int pos = (g128 & 1) ? (tok & 63) : ((tok >> 6) & 63);
#pragma unroll
      for (int r = 0; r < 16; ++r) {
        const int fi = 32 * wm + crow(r, hie);
        float x1 = acc[0][tn][r], x2 = acc[1][tn][r];
        if (tok < TL) { const f32x2 cs = rope_cs(pos, fi, 13.287712379549449f / 64.f); const float y1 = x1 * cs.x - x2 * cs.y, y2 = x1 * cs.y + x2 * cs.x; x1 = y1; x2 = y2; }
        *(bf16_t*)(img + fi * IST + cl * 2) = f2bf(x1 * J.scale); *(bf16_t*)(img + (fi + 64) * IST + cl * 2) = f2bf(x2 * J.scale);
      }
    }
    obase = (bf16_t*)J.out + (size_t)J.m0 * T + J.n0; oldc = T;
  } else if (J.epi == EPI_ROPE_DIFF_N) {
    const int fi = l31e & 15, c1 = 64 * wn + (l31e < 16 ? l31e : l31e + 16);
#pragma unroll
    for (int tm = 0; tm < 2; ++tm)
#pragma unroll
      for (int r = 0; r < 16; ++r) {
        const int rl = 64 * wm + 32 * tm + crow(r, hie), row = J.m0 + rl;
        float x1 = acc[tm][0][r], x2 = acc[tm][1][r];
        if (row < TL) { const int pos = (l31e < 16) ? ((row >> 6) & 63) : (row & 63); const f32x2 cs = rope_cs(pos, fi, 13.287712379549449f / 16.f); const float y1 = x1 * cs.x - x2 * cs.y, y2 = x1 * cs.y + x2 * cs.x; x1 = y1; x2 = y2; }
        *(bf16_t*)(img + rl * IST + c1 * 2) = f2bf(x1); *(bf16_t*)(img + rl * IST + (c1 + 16) * 2) = f2bf(x2);
      }
    obase = (bf16_t*)J.out + (size_t)J.m0 * 1024 + J.n0; oldc = 1024;
  } else if (J.epi == EPI_SMASK) {
    const int il4 = J.aux, hh = il4 & 3;
    const float lgf = -log2f(1.f + expf(-P.ret_df[il4])), lgb = -log2f(1.f + expf(-P.ret_db[il4]));
#pragma unroll
    for (int d = 0; d < 2; ++d) {
#pragma unroll
      for (int tm = 0; tm < 2; ++tm)
#pragma unroll
        for (int tn = 0; tn < 2; ++tn)
#pragma unroll
          for (int r = 0; r < 16; ++r) {
            const int i = 64 * wm + 32 * tm + crow(r, hie), j = 64 * wn + 32 * tn + l31e, dd = d ? j - i : i - j;
            const float v = dd >= 0 ? acc[tm][tn][r] * ex2((d ? lgb : lgf) * (float)dd) : 0.f;
            *(bf16_t*)(img + i * IST + j * 2) = f2bf(v);
          }
      __syncthreads();
      bf16_t* ob2 = (bf16_t*)J.out + (size_t)J.m0 * 1024 + hh * 256 + d * 128;
#pragma unroll
      for (int i = 0; i < 8; ++i) { const int c = tid + 256 * i, row = c >> 4, cc = c & 15, hb = ((d * 4 + (row >> 5)) * 8 + (cc >> 1)) * 2 + (cc & 1);
        *(u32x4*)((bf16_t*)J.out + (size_t)(J.m0 + hb) * 1024 + hh * 256 + (row & 31) * 8) = *(const u32x4*)(img + row * IST + cc * 16); }
      __syncthreads();
    }
    return;
  } else if (J.epi == EPI_ACT) {
#pragma unroll
    for (int tm = 0; tm < 2; ++tm)
#pragma unroll
      for (int tn = 0; tn < 2; ++tn)
#pragma unroll
        for (int r = 0; r < 16; ++r) *(bf16_t*)(img + (64 * wm + 32 * tm + crow(r, hie)) * IST + (64 * wn + 32 * tn + l31e) * 2) = f2bf(acc[tm][tn][r]);
    __syncthreads();
    {
      const int ch = tid & 7, rg = tid >> 3, f0 = 64 * (J.n0 >> 7) + 8 * ch;
      const float* cw = P.ffn_cw + (size_t)J.aux * 3 * 2816; const float* cb = P.ffn_cb + (size_t)J.aux * 2816;
      float w0[8], w1[8], w2[8], bb[8];
#pragma unroll
      for (int j = 0; j < 8; ++j) { w0[j] = cw[f0 + j]; w1[j] = cw[2816 + f0 + j]; w2[j] = cw[5632 + f0 + j]; bb[j] = cb[f0 + j]; }
      const int slen = J.m0 < TL ? 4096 : 256, p0 = J.m0 < TL ? (J.m0 & 4095) : ((J.m0 - TL) & 255);
      const bool sstart = p0 == 0, send = p0 + 128 == slen;
      u32x4 g[6], vv[4];
#pragma unroll
      for (int qd = 0; qd < 6; ++qd) { const int lr = 4 * rg - 1 + qd; g[qd] = (u32x4){0, 0, 0, 0}; if (lr >= 0 && lr < 128) g[qd] = *(const u32x4*)(img + lr * IST + (64 + 8 * ch) * 2); }
#pragma unroll
      for (int qd = 0; qd < 4; ++qd) vv[qd] = *(const u32x4*)(img + (4 * rg + qd) * IST + 8 * ch * 2);
      bf16_t* aout = (bf16_t*)J.out; bf16_t* vgb = (bf16_t*)(P.ws + OFF_AR);
#pragma unroll
      for (int qd = 0; qd < 4; ++qd) {
        const int lr = 4 * rg + qd;
        float o[8];
#pragma unroll
        for (int k2 = 0; k2 < 4; ++k2) {
          const float x0 = w0[2 * k2] * bflo(g[qd][k2]) + w1[2 * k2] * bflo(g[qd + 1][k2]) + w2[2 * k2] * bflo(g[qd + 2][k2]) + bb[2 * k2];
          const float x1 = w0[2 * k2 + 1] * bfhi(g[qd][k2]) + w1[2 * k2 + 1] * bfhi(g[qd + 1][k2]) + w2[2 * k2 + 1] * bfhi(g[qd + 2][k2]) + bb[2 * k2 + 1];
          o[2 * k2] = siluf(x0) * bflo(vv[qd][k2]); o[2 * k2 + 1] = siluf(x1) * bfhi(vv[qd][k2]);
        }
        if ((lr > 0 || sstart) && (lr < 127 || send)) {
          u32x4 ov; ov.x = pk2(o[0], o[1]); ov.y = pk2(o[2], o[3]); ov.z = pk2(o[4], o[5]); ov.w = pk2(o[6], o[7]);
          *(u32x4*)(aout + (size_t)(J.m0 + lr) * 2816 + f0) = ov;
        }
        if (lr < 2 || lr > 125) {
          *(u32x4*)(vgb + (size_t)(J.m0 + lr) * 5632 + f0) = vv[qd];
          *(u32x4*)(vgb + (size_t)(J.m0 + lr) * 5632 + 2816 + f0) = g[qd + 1];
        }
      }
    }
    __syncthreads();
    return;
  } else {
    constexpr int MST = 144;
    char* oft = lds + 18432; char* obt = lds + 36864; float* rs = (float*)(lds + 55296);
    const int f0 = J.n0 >> 1, hd = f0 >> 9;
    const bf16_t* of = (const bf16_t*)(P.ws + OFF_AR + 5 * SZ_U); const bf16_t* ob = (const bf16_t*)(P.ws + OFF_AR + 7 * SZ_U);
    {
      const int row = tid & 127, dir = tid >> 7;
      const float* sp = (const float*)(P.ws + OFF_SSQ) + (dir ? (size_t)T * 64 : 0) + ((size_t)(J.m0 + row) * 4 + hd) * 16;
      float sm = 0.f;
#pragma unroll
      for (int qd = 0; qd < 4; ++qd) { const f32x4 pv = *(const f32x4*)(sp + 4 * qd); sm += (pv.x + pv.y) + (pv.z + pv.w); }
      rs[tid] = rsqrtf(sm * (1.f / 512.f) + EPS);
#pragma unroll
      for (int i = 0; i < 4; ++i) {
        const int c = tid + 256 * i, r2 = c >> 3, cc = c & 7;
        *(u32x4*)(oft + r2 * MST + cc * 16) = *(const u32x4*)(of + (size_t)(J.m0 + r2) * 2048 + f0 + cc * 8);
        *(u32x4*)(obt + r2 * MST + cc * 16) = *(const u32x4*)(ob + (size_t)(J.m0 + r2) * 2048 + f0 + cc * 8);
      }
    }
    __syncthreads();
    const int cl = 32 * wn + l31e;
#pragma unroll
    for (int tm = 0; tm < 2; ++tm)
#pragma unroll
      for (int r = 0; r < 16; ++r) {
        const int rl = 64 * wm + 32 * tm + crow(r, hie);
        const float vf = bf2f(*(const bf16_t*)(oft + rl * MST + cl * 2)) * rs[rl], vb = bf2f(*(const bf16_t*)(obt + rl * MST + cl * 2)) * rs[128 + rl];
        *(bf16_t*)(img + rl * MST + cl * 2) = f2bf(siluf(acc[tm][0][r]) * vf + siluf(acc[tm][1][r]) * vb);
      }
    obase = (bf16_t*)J.out + (size_t)J.m0 * 2048 + f0; oldc = 2048; ocols = 64; ist = MST;
  }
  __syncthreads();
  if (ocols == 128 && (J.aux & 2)) {
    const int ci = J.n0 >> 7;
#pragma unroll
    for (int i = 0; i < 8; ++i) {
      const int c = tid + 256 * i, row = c >> 4, cc = c & 15, gt = (J.m0 + row) >> 5;
      bf16_t* dst = (bf16_t*)J.out + ((((size_t)gt * 136 + ci) * 8 + (cc >> 1)) * 64 + (cc & 1) * 32 + (row & 31)) * 8;
      *(u32x4*)dst = *(const u32x4*)(img + row * ist + cc * 16);
    }
  } else if (ocols == 128 && (J.aux & 8)) {
    const int hq = J.n0 >> 8, s0 = ((J.n0 >> 7) & 1) * 8;
#pragma unroll
    for (int i = 0; i < 8; ++i) {
      const int c = tid + 256 * i, row = c >> 4, cc = c & 15, rt = (J.m0 + row) >> 5;
      bf16_t* dst = (bf16_t*)J.out + ((((size_t)rt * 4 + hq) * 16 + s0 + (cc >> 1)) * 64 + (cc & 1) * 32 + (row & 31)) * 8;
      *(u32x4*)dst = *(const u32x4*)(img + row * ist + cc * 16);
    }
  } else if (ocols == 128) {
#pragma unroll
    for (int i = 0; i < 8; ++i) { const int c = tid + 256 * i, row = c >> 4, cc = c & 15; *(u32x4*)(obase + (size_t)row * oldc + cc * 8) = *(const u32x4*)(img + row * ist + cc * 16); }
  } else {
#pragma unroll
    for (int i = 0; i < 4; ++i) { const int c = tid + 256 * i, row = c >> 3, cc = c & 7; *(u32x4*)(obase + (size_t)row * oldc + cc * 8) = *(const u32x4*)(img + row * ist + cc * 16); }
  }
  if (J.aux & 32) {
    bf16_t* ktf = (bf16_t*)(P.ws + OFF_AR + 2 * SZ_U);
    const int ci = J.m0 >> 7;
#pragma unroll
    for (int i = 0; i < 8; ++i) {
      const int c = tid + 256 * i, dl = c & 127, jc = c >> 7;
      const char* src = img + (8 * jc) * ist + dl * 2;
      u32x4 v;
      v.x = (unsigned)*(const bf16_t*)(src) | ((unsigned)*(const bf16_t*)(src + ist) << 16);
      v.y = (unsigned)*(const bf16_t*)(src + 2 * ist) | ((unsigned)*(const bf16_t*)(src + 3 * ist) << 16);
      v.z = (unsigned)*(const bf16_t*)(src + 4 * ist) | ((unsigned)*(const bf16_t*)(src + 5 * ist) << 16);
      v.w = (unsigned)*(const bf16_t*)(src + 6 * ist) | ((unsigned)*(const bf16_t*)(src + 7 * ist) << 16);
      bf16_t* dst = ktf + (((((size_t)((J.n0 + dl) >> 5) * 136 + ci) * 8 + (jc >> 1)) * 64) + (jc & 1) * 32 + (dl & 31)) * 8;
      *(u32x4*)dst = v;
    }
  }
  __syncthreads();
}

DI void tile_mn(int idx, int nN, int& tm, int& tn) { const int per = 8 * nN, mg = idx / per, rem = idx % per; tn = rem >> 3; tm = mg * 8 + (rem & 7); }

enum { GP_RET_IN = 0, GP_RET_GATE, GP_RET_OUT, GP_DIFF_IN, GP_DIFF_OUT, GP_FFN_UP, GP_FFN_DOWN, GP_RET_S };
DI void gemm_phase(const Params& P, int kind, char* lds, int layer, int wid_s) {
  const bf16_t* U = (const bf16_t*)(P.ws + OFF_U); const bf16_t* WM = (const bf16_t*)(P.ws + OFF_WM); const bf16_t* WF = (const bf16_t*)(P.ws + OFF_WF);
  char* AR = P.ws + OFF_AR;
  int total;
  switch (kind) {
    case GP_RET_IN: total = 1088 * 4; break;
    case GP_RET_S: total = 544; break;
    case GP_RET_GATE: total = 136 * 32; break;
    case GP_DIFF_IN: total = 1088 * 3; break;
    case GP_FFN_UP: total = (layer == 3 ? 128 : 136) * 44; break;
    default: total = layer == 3 ? 1024 : 1024 + 256; break;
  }
  const int G = gridDim.x, per = G >> 3; const int tid = otid();
  for (int base = 0; base < total; base += G) {
    int L = base + ((G & 7) == 0 ? (int)(blockIdx.x & 7) * per + (int)(blockIdx.x >> 3) : (int)blockIdx.x);
    if (L >= total) continue;
    Job J; J.lda = 1024; J.ldb = 1024; J.K = 1024; J.scale = 1.f; J.ldc = 1024; J.aux = 0; J.afrag = 0;
    int tm, tn;
    if (kind == GP_RET_S) { const int hh = L & 3, ci = L >> 2; tm = ci; tn = ci; J.A = (const bf16_t*)AR; J.afrag = 1 + hh; J.B = (const bf16_t*)(AR + SZ_U) + hh * 256; J.K = 256; J.epi = EPI_SMASK; J.out = AR + SZ_U; J.aux = (layer >> 1) * 4 + hh; }
    else if (kind == GP_RET_IN) {
      if (L < 1088) { tile_mn(L, 8, tm, tn); J.A = U; J.B = WM; J.epi = EPI_ROPE_RET_N; J.out = AR; J.aux = 8; }
      else if (L < 2176) { tile_mn(L - 1088, 8, tm, tn); J.A = U; J.B = WM + (size_t)1024 * 1024; J.epi = EPI_ROPE_RET_N; J.out = AR + SZ_U; J.scale = 0.0625f; J.aux = 32; }
      else { tile_mn(L - 2176, 136, tm, tn); J.A = WM + (size_t)2048 * 1024; J.B = U; J.epi = EPI_BF16; J.out = AR + 3 * SZ_U; J.ldc = T; J.aux = 2; }
    } else if (kind == GP_RET_GATE) { tile_mn(L, 32, tm, tn); J.A = U; J.B = WM + (size_t)4096 * 1024; J.epi = EPI_MERGE; J.out = AR; }
    else if (kind == GP_RET_OUT) { tile_mn(L < 1024 ? L : 1024 + ((L - 1024) >> 2), 8, tm, tn); J.A = (const bf16_t*)AR; J.lda = 2048; J.B = WM + (size_t)8192 * 1024; J.ldb = 2048; J.K = 2048; J.epi = EPI_BF16; J.out = AR + 3 * SZ_U; }
    else if (kind == GP_DIFF_IN) {
      if (L < 1088) { tile_mn(L, 8, tm, tn); J.A = U; J.B = WM; J.epi = EPI_ROPE_DIFF_N; J.out = AR; }
      else if (L < 2176) { tile_mn(L - 1088, 8, tm, tn); J.A = U; J.B = WM + (size_t)1024 * 1024; J.epi = EPI_ROPE_DIFF_N; J.out = AR + SZ_U; }
      else { tile_mn(L - 2176, 136, tm, tn); J.A = WM + (size_t)2048 * 1024; J.B = U; J.epi = EPI_BF16; J.out = AR + 2 * SZ_U; J.ldc = T; J.aux = 1; }
    } else if (kind == GP_DIFF_OUT) { tile_mn(L < 1024 ? L : 1024 + ((L - 1024) >> 2), 8, tm, tn); J.A = (const bf16_t*)(AR + 5 * SZ_U); J.B = WM + (size_t)3072 * 1024; J.epi = EPI_BF16; J.out = AR + 3 * SZ_U; }
    else if (kind == GP_FFN_UP) { tile_mn(L, 44, tm, tn); J.A = U; J.B = WF; J.epi = EPI_ACT; J.out = AR + 6 * SZ_U; J.aux = layer; }
    else { tile_mn(L < 1024 ? L : 1024 + ((L - 1024) >> 2), 8, tm, tn); J.A = (const bf16_t*)(AR + 6 * SZ_U); J.lda = 2816; J.B = WF + (size_t)5632 * 1024; J.ldb = 2816; J.K = 2816; J.epi = EPI_BF16; J.out = AR; }
    if ((kind == GP_RET_OUT || kind == GP_DIFF_OUT || kind == GP_FFN_DOWN) && L >= 1024) {
      const int kp = (L - 1024) & 3, kq = J.K >> 2;
      J.A += kp * kq; J.B += kp * kq; J.K = kq; J.epi = EPI_F32; J.ldc = 1024;
      J.out = (float*)(AR + 4 * SZ_U) + (size_t)kp * 1024 * 1024 - (size_t)TL * 1024;
    }
    J.m0 = tm * 128; J.n0 = tn * 128;
    gemm_tile(P, J, lds, tid);
  }
}

DI void write_rt(const f32x16 (&accR)[2], char* lds, int w, int l31, int hi) {
#pragma unroll
  for (int td = 0; td < 2; ++td)
#pragma unroll
    for (int g = 0; g < 4; ++g) {
      const int d = 64 * w + 32 * td + 8 * g + 4 * hi, v = l31;
      u32x2 pk; pk.x = pk2(accR[td][4 * g], accR[td][4 * g + 1]); pk.y = pk2(accR[td][4 * g + 2], accR[td][4 * g + 3]);
      *(u32x2*)(lds + v * 512 + (((d >> 3) ^ (v & 15)) << 4) + (d & 7) * 2) = pk;
    }
}
DI int ret_r0(int cc, int dir, int b) { return cc < 2 ? TL + b * 256 + 128 * (dir ? 1 - cc : cc) : b * 4096 + 128 * (dir ? 33 - cc : cc - 2); }
DI void ret_phase(const Params& P, int l, char* lds, int wid_s) {
  const int tid = otid(), lane = tid & 63, w = tid >> 6, l31 = lane & 31, hi = lane >> 5, il = l >> 1;
  const char* q = P.ws + OFF_AR; const char* pd = P.ws + OFF_AR + SZ_U;
  const char* kT = P.ws + OFF_AR + 2 * SZ_U; const char* vT = P.ws + OFF_AR + 3 * SZ_U;
  for (int item = blockIdx.x; item < 512; item += gridDim.x) {
    const int dvs = item & 15, dir = (item >> 4) & 1, hh = (item >> 5) & 3, b = item >> 7;
    const float logit = (dir ? P.ret_db : P.ret_df)[il * 4 + hh];
    const float l2g = -log2f(1.f + expf(-logit));
    const float cdec = ex2(l2g * 128.f);
    const float gstep = ex2(dir ? l2g : -l2g);
    char* obuf = P.ws + OFF_AR + (dir ? 7 : 5) * SZ_U;
    float* ssq = (float*)(P.ws + OFF_SSQ) + (dir ? (size_t)T * 64 : 0);
    f32x16 accR[2];
#pragma unroll
    for (int a = 0; a < 2; ++a)
#pragma unroll
      for (int r = 0; r < 16; ++r) accR[a][r] = 0.f;
    __syncthreads();
    write_rt(accR, lds, w, l31, hi);
    __syncthreads();
    bf16x8 pa[8], bv[8], bq[16];
    {
      const int r0 = ret_r0(0, dir, b);
      const unsigned po = (unsigned)((((((r0 >> 5) + w) * 4 + hh) * 16) * 64) + lane) * 16u;
      const unsigned pf = (unsigned)((r0 + (dir * 4 + w) * 16 + hi) * 1024 + hh * 256 + l31 * 8) * 2u;
      const unsigned vo = (unsigned)((((hh * 16 + dvs) * 136 + (r0 >> 7)) * 8) * 64 + lane) * 16u;
#pragma unroll
      for (int s = 0; s < 8; ++s) { pa[s] = *(const bf16x8*)(pd + (pf + 4096u * s)); bv[s] = *(const bf16x8*)(vT + (vo + 1024u * s)); }
#pragma unroll
      for (int s = 0; s < 16; ++s) bq[s] = *(const bf16x8*)(q + (po + 1024u * s));
    }
    for (int cc = 0; cc < 34; ++cc) {
      float lg = l2g; int hiv = hi, l31v = l31; asm volatile("" : "+v"(lg), "+v"(hiv), "+v"(l31v));
      const int r0 = ret_r0(cc, dir, b);
      f32x16 accO, accQ;
#pragma unroll
      for (int r = 0; r < 16; ++r) { accO[r] = 0.f; accQ[r] = 0.f; }
#pragma unroll
      for (int s = 0; s < 8; ++s) accO = MFMA(pa[s], bv[s], accO);
#pragma unroll
      for (int s = 0; s < 16; ++s) { const bf16x8 br = *(const bf16x8*)(lds + l31v * 512 + (((2 * s + hiv) ^ (l31v & 15)) << 4)); accQ = MFMA(bq[s], br, accQ); }
#pragma unroll
      for (int r = 0; r < 16; ++r) {
        const int i2 = 32 * w + crow(r, hiv); const float e = dir ? (float)(128 - i2) : (float)(i2 + 1);
        const float o = accO[r] + ex2(lg * e) * accQ[r];
        const int row = r0 + i2;
        *(bf16_t*)(obuf + (unsigned)(row * 2048 + hh * 512 + dvs * 32 + l31v) * 2u) = f2bf(o);
        float sq = o * o;
        sq = dpp_xadd<0xB1>(sq); sq = dpp_xadd<0x4E>(sq); sq = dpp_xadd<0x141>(sq); sq = dpp_xadd<0x140>(sq);
        sq += __shfl_xor(sq, 16);
        if (l31v == 0) ssq[(row * 4 + hh) * 16 + dvs] = sq;
      }
      __builtin_amdgcn_sched_barrier(0);
      bf16x8 ak[2][8];
      if (cc < 33) {
        const unsigned kto = (unsigned)((((hh * 8 + 2 * w) * 136 + (r0 >> 7)) * 8) * 64 + l31v + 32 * hiv) * 16u;
#pragma unroll
        for (int td = 0; td < 2; ++td)
#pragma unroll
          for (int s = 0; s < 8; ++s) ak[td][s] = *(const bf16x8*)(kT + (kto + (unsigned)(td * 136 * 8 * 64 * 16) + 1024u * s));
      }
      if (cc < 33) {
#pragma unroll
        for (int a = 0; a < 2; ++a)
#pragma unroll
          for (int r = 0; r < 16; ++r) accR[a][r] *= cdec;
#pragma unroll
        for (int s = 0; s < 8; ++s) {
          float z[8];
          { const int j0 = 16 * s + 8 * hiv; z[0] = ex2(lg * (float)(dir ? j0 : 127 - j0));
#pragma unroll
            for (int e = 1; e < 8; ++e) z[e] = z[e - 1] * gstep; }
          const u32x4 raw = __builtin_bit_cast(u32x4, bv[s]);
          u32x4 sc;
          sc.x = pk2(bflo(raw.x) * z[0], bfhi(raw.x) * z[1]); sc.y = pk2(bflo(raw.y) * z[2], bfhi(raw.y) * z[3]);
          sc.z = pk2(bflo(raw.z) * z[4], bfhi(raw.z) * z[5]); sc.w = pk2(bflo(raw.w) * z[6], bfhi(raw.w) * z[7]);
          const bf16x8 bvs = __builtin_bit_cast(bf16x8, sc);
          accR[0] = MFMA(ak[0][s], bvs, accR[0]); accR[1] = MFMA(ak[1][s], bvs, accR[1]);
        }
        const int r1 = ret_r0(cc + 1, dir, b);
        const unsigned po = (unsigned)((((((r1 >> 5) + w) * 4 + hh) * 16) * 64) + l31v + 32 * hiv) * 16u;
        const unsigned pf = (unsigned)((r1 + (dir * 4 + w) * 16 + hiv) * 1024 + hh * 256 + l31v * 8) * 2u;
        const unsigned vo = (unsigned)((((hh * 16 + dvs) * 136 + (r1 >> 7)) * 8) * 64 + l31v + 32 * hiv) * 16u;
#pragma unroll
        for (int s = 0; s < 8; ++s) { pa[s] = *(const bf16x8*)(pd + (pf + 4096u * s)); bv[s] = *(const bf16x8*)(vT + (vo + 1024u * s)); }
#pragma unroll
        for (int s = 0; s < 16; ++s) bq[s] = *(const bf16x8*)(q + (po + 1024u * s));
        __builtin_amdgcn_sched_barrier(0);
        __syncthreads();
        write_rt(accR, lds, w, l31v, hiv);
        __syncthreads();
      }
    }
  }
}

DI void att_phase(const Params& P, int l, char* lds, int wid_s) {
  const int tid = otid(), lane = tid & 63, w = tid >> 6, l31 = lane & 31, hi = lane >> 5, il = l >> 1;
  const bf16_t* q = (const bf16_t*)(P.ws + OFF_AR); const bf16_t* k = (const bf16_t*)(P.ws + OFF_AR + SZ_U);
  const bf16_t* vT = (const bf16_t*)(P.ws + OFF_AR + 2 * SZ_U); bf16_t* att = (bf16_t*)(P.ws + OFF_AR + 5 * SZ_U);
  const float csc = 0.125f * 1.4426950408889634f;
  for (int item = blockIdx.x; item < (l == 3 ? 1024 : 1024 + 64); item += gridDim.x) {
    int b, hh, R0, nt, nlat;
    if (item < 1024) { b = item >> 8; hh = (item >> 5) & 7; R0 = b * 4096 + 128 * (item & 31); nt = 68; nlat = 64; }
    else { const int i2 = item - 1024; b = i2 >> 4; hh = (i2 >> 1) & 7; R0 = TL + b * 256 + 128 * (i2 & 1); nt = 4; nlat = 0; }
    const int qrow = R0 + 32 * w + l31;
    bf16x8 bq[2][4];
#pragma unroll
    for (int r2 = 0; r2 < 2; ++r2)
#pragma unroll
      for (int s = 0; s < 4; ++s) bq[r2][s] = *(const bf16x8*)(q + (size_t)qrow * 1024 + hh * 128 + 64 * r2 + 16 * s + 8 * hi);
    f32x16 oT[2][4];
#pragma unroll
    for (int r2 = 0; r2 < 2; ++r2)
#pragma unroll
      for (int a = 0; a < 4; ++a)
#pragma unroll
        for (int r = 0; r < 16; ++r) oT[r2][a][r] = 0.f;
    float mrun[2] = {-1e30f, -1e30f}, lsum[2] = {0.f, 0.f};
    auto keybase = [&](int t) { return t < nlat ? b * 4096 + 64 * t : TL + b * 256 + 64 * (t - nlat); };
    auto dma = [&](int t, int buf) {
      int t2 = tid; asm volatile("" : "+v"(t2));
      const int kch = (t2 & 15) ^ ((t2 >> 4) & 15), krow_l = t2 >> 4;
      const int vch = (t2 & 7) ^ ((t2 >> 4) & 7), vrow_l = t2 >> 3;
      const int kb = keybase(t);
      const unsigned ko = (unsigned)((kb + krow_l) * 1024 + hh * 128 + kch * 8) * 2u;
      const unsigned vo = (unsigned)((hh * 128 + vrow_l) * T + kb + vch * 8) * 2u;
      char* kd = lds + buf * 16384 + t2 * 16; char* vd = lds + 32768 + buf * 16384 + t2 * 16;
#pragma unroll
      for (int i = 0; i < 4; ++i) {
        GLDS((const char*)k + (ko + (unsigned)(i * 16 * 1024 * 2)), kd + i * 4096);
        GLDS((const char*)vT + (vo + (unsigned)(i * 32 * T * 2)), vd + i * 4096);
      }
    };
    __syncthreads();
    dma(0, 0);
    asm volatile("s_waitcnt vmcnt(0)" ::: "memory");
    __syncthreads();
    for (int t = 0; t < nt; ++t) {
      const char* kb_ = lds + (t & 1) * 16384; const char* vb_ = lds + 32768 + (t & 1) * 16384;
      if (t + 1 < nt) dma(t + 1, (t + 1) & 1);
#pragma unroll
      for (int r2 = 0; r2 < 2; ++r2) {
        int l31v = l31, hiv = hi; asm volatile("" : "+v"(l31v), "+v"(hiv));
        f32x16 st[2];
#pragma unroll
        for (int jt = 0; jt < 2; ++jt) {
#pragma unroll
          for (int r = 0; r < 16; ++r) st[jt][r] = 0.f;
          const int row = 32 * jt + l31v;
#pragma unroll
          for (int s = 0; s < 4; ++s) { const bf16x8 ak = *(const bf16x8*)(kb_ + row * 256 + (((8 * r2 + 2 * s + hiv) ^ (row & 15)) << 4)); st[jt] = MFMA(ak, bq[r2][s], st[jt]); }
        }
        float mx = st[0][0];
#pragma unroll
        for (int r = 1; r < 16; ++r) mx = fmaxf(mx, st[0][r]);
#pragma unroll
        for (int r = 0; r < 16; ++r) mx = fmaxf(mx, st[1][r]);
        mx = fmaxf(mx, __shfl_xor(mx, 32));
        const float mnew = fmaxf(mrun[r2], mx * csc), alpha = ex2(mrun[r2] - mnew);
        mrun[r2] = mnew;
        float ps = 0.f;
#pragma unroll
        for (int jt = 0; jt < 2; ++jt)
#pragma unroll
          for (int r = 0; r < 16; ++r) { const float p = ex2(st[jt][r] * csc - mnew); st[jt][r] = p; ps += p; }
        lsum[r2] = lsum[r2] * alpha + ps;
#pragma unroll
        for (int a = 0; a < 4; ++a)
#pragma unroll
          for (int r = 0; r < 16; ++r) oT[r2][a][r] *= alpha;
#pragma unroll
        for (int jt = 0; jt < 2; ++jt)
#pragma unroll
          for (int s2 = 0; s2 < 2; ++s2) {
            const bf16x8 pb = pack8(st[jt], s2);
            const int chunk = 4 * jt + 2 * s2 + hiv;
#pragma unroll
            for (int tv = 0; tv < 4; ++tv) {
              const int v = 32 * tv + l31v, sw = (v >> 1) & 7;
              const bf16x8 av = *(const bf16x8*)(vb_ + v * 128 + ((chunk ^ sw) << 4));
              oT[r2][tv] = MFMA(av, pb, oT[r2][tv]);
              if (tv & 1) __builtin_amdgcn_sched_barrier(0);
            }
          }
      }
      asm volatile("s_waitcnt vmcnt(0)" ::: "memory");
      __syncthreads();
    }
    lsum[0] += __shfl_xor(lsum[0], 32); lsum[1] += __shfl_xor(lsum[1], 32);
    int lv = l; asm volatile("" : "+s"(lv));
    const float lam_init = (lv == 1) ? 0.3555090676f : 0.5560582042f;
    float d1 = 0.f, d2 = 0.f;
    for (int e = 0; e < 64; ++e) { d1 += P.lq1[il * 64 + e] * P.lk1[il * 64 + e]; d2 += P.lq2[il * 64 + e] * P.lk2[il * 64 + e]; }
    const float lam = ex2(d1 * 1.4426950408889634f) - ex2(d2 * 1.4426950408889634f) + lam_init;
    const float inv0 = __builtin_amdgcn_rcpf(lsum[0]), inv1 = lam * __builtin_amdgcn_rcpf(lsum[1]);
    float ss = 0.f;
#pragma unroll
    for (int a = 0; a < 4; ++a)
#pragma unroll
      for (int r = 0; r < 16; ++r) { const float o = oT[0][a][r] * inv0 - oT[1][a][r] * inv1; oT[0][a][r] = o; ss += o * o; }
    ss += __shfl_xor(ss, 32);
    const float rstd = __builtin_amdgcn_rsqf(ss * (1.f / 128.f) + EPS) * (1.f - lam_init);
    const float* sg = P.subln + il * 128;
    int t3 = tid; asm volatile("" : "+v"(t3));
    const int qrow2 = R0 + 32 * (t3 >> 6) + (t3 & 31), hi3 = (t3 >> 5) & 1;
#pragma unroll
    for (int a = 0; a < 4; ++a)
#pragma unroll
      for (int g = 0; g < 4; ++g) {
        const int v = 32 * a + 8 * g + 4 * hi3;
        const f32x4 gg = *(const f32x4*)(sg + v);
        u32x2 pk; pk.x = pk2(oT[0][a][4 * g] * rstd * gg.x, oT[0][a][4 * g + 1] * rstd * gg.y); pk.y = pk2(oT[0][a][4 * g + 2] * rstd * gg.z, oT[0][a][4 * g + 3] * rstd * gg.w);
        *(u32x2*)(att + (size_t)qrow2 * 1024 + hh * 128 + v) = pk;
      }
  }
}

__global__ void __launch_bounds__(NTH, 2) fwd_kernel(Params P) {
  __shared__ __attribute__((aligned(16))) char lds[65536];
  cg::grid_group grid = cg::this_grid();
  int ph = 0;
  __shared__ unsigned xb_st[4];
  const int wid_s = __builtin_amdgcn_readfirstlane((int)threadIdx.x >> 6);
  if (wid_s == 0 && lane_id() < 4) xb_st[lane_id()] = 0u;
  __syncthreads();
  const XcdBarrier xb = xcd_barrier_post((unsigned*)(P.ws + OFF_BAR), (volatile LAS unsigned*)xb_st, wid_s);
  const bf16_t* ymix = (const bf16_t*)(P.ws + OFF_AR + 3 * SZ_U); const bf16_t* yffn = (const bf16_t*)(P.ws + OFF_AR);
#define PHASE_BEGIN if (ph >= P.lo && ph < P.hi) {
#define PHASE_END if (ph + 1 < P.hi) { if (P.lo < 0) grid.sync(); xcd_barrier(xb, wid_s); } } ++ph;
#ifndef PH_MASK
#define PH_MASK 0xffff
#endif
#define HAS(n) ((PH_MASK >> (n)) & 1)
#ifndef REP
#define REP 0
#endif
#define NREP(n) (((REP >> (n)) & 1) ? 2 : 1)
  PHASE_BEGIN
#if HAS(0)
    for (int rr = 0; rr < NREP(0); ++rr) mod_phase(P, lds, wid_s);
#endif
#if HAS(1)
    for (int rr = 0; rr < NREP(1); ++rr) { int base = 384; conv_mixer(P, 0, lds, base, wid_s); conv_ffn(P, 0, lds, base, wid_s); }
#endif
  PHASE_END
  for (int l = 0; l < 4; ++l) {
    const bool ret = (l & 1) == 0;
    PHASE_BEGIN
#if HAS(2)
      if (l == 0) pn_phase(P, -1, 0, 0, 0, true, nullptr, wid_s); else pn_phase(P, l - 1, 1, l, 0, false, yffn, wid_s);
#endif
#if HAS(1)
      if (l > 0) for (int rr = 0; rr < NREP(1); ++rr) { int base = 0; conv_ffn(P, l, lds, base, wid_s); }
#endif
    PHASE_END
    PHASE_BEGIN
#if HAS(3)
      for (int rr = 0; rr < NREP(3); ++rr) gemm_phase(P, ret ? GP_RET_IN : GP_DIFF_IN, lds, l, wid_s);
#endif
    PHASE_END
    if (ret) { PHASE_BEGIN
#if HAS(3)
      gemm_phase(P, GP_RET_S, lds, l, wid_s);
#endif
    PHASE_END }
    PHASE_BEGIN
#if HAS(4)
      if (ret) for (int rr = 0; rr < NREP(4); ++rr) ret_phase(P, l, lds, wid_s);
#endif
#if HAS(5)
      if (!ret) for (int rr = 0; rr < NREP(5); ++rr) att_phase(P, l, lds, wid_s);
#endif
    PHASE_END
    if (ret) { PHASE_BEGIN
#if HAS(3)
      for (int rr = 0; rr < NREP(3); ++rr) gemm_phase(P, GP_RET_GATE, lds, l, wid_s);
#endif
    PHASE_END }
    PHASE_BEGIN
#if HAS(3)
      for (int rr = 0; rr < NREP(3); ++rr) gemm_phase(P, ret ? GP_RET_OUT : GP_DIFF_OUT, lds, l, wid_s);
#endif
    PHASE_END
    PHASE_BEGIN
#if HAS(2)
      pn_phase(P, l, 0, l, 1, l == 0, ymix, wid_s);
#endif
#if HAS(1)
      if (l < 3) for (int rr = 0; rr < NREP(1); ++rr) { int base = 0; conv_mixer(P, l + 1, lds, base, wid_s); }
#endif
    PHASE_END
    PHASE_BEGIN
#if HAS(3)
      for (int rr = 0; rr < NREP(3); ++rr) gemm_phase(P, GP_FFN_UP, lds, l, wid_s);
#endif
    PHASE_END
    PHASE_BEGIN
#if HAS(6)
      for (int rr = 0; rr < NREP(6); ++rr) act_phase(P, l, wid_s);
#endif
    PHASE_END
    PHASE_BEGIN
#if HAS(3)
      for (int rr = 0; rr < NREP(3); ++rr) gemm_phase(P, GP_FFN_DOWN, lds, l, wid_s);
#endif
    PHASE_END
  }
  PHASE_BEGIN
#if HAS(2)
    pn_phase(P, 3, 1, -1, 0, false, yffn, wid_s);
#endif
  PHASE_END
}
constexpr int N_PHASES = 1 + 10 + 8 + 10 + 8 + 1;
#ifdef STOP_AT
__global__ void dump_kernel(const unsigned short* ws, float* out, size_t nws16) {
  size_t i = (size_t)blockIdx.x * 256 + threadIdx.x;
  unsigned acc = 0;
  for (size_t j = i; j < nws16; j += (size_t)TL * 1024) acc = acc * 31u + ws[j];
  out[i] = (float)(acc & 0xFFFFu) * (1.f / 65536.f);
}
#endif

extern "C" void kernel_launch(void* const* d_in, const int* in_sizes, int n_in, void* d_out, int out_size, void* d_ws, size_t ws_size, hipStream_t stream) {
  static int grid_blocks = 0;
  if (!grid_blocks) {
    int dev = 0, cus = 0, per_cu = 0;
    hipGetDevice(&dev);
    hipDeviceGetAttribute(&cus, hipDeviceAttributeMultiprocessorCount, dev);
    hipOccupancyMaxActiveBlocksPerMultiprocessor(&per_cu, fwd_kernel, NTH, 0);
    if (per_cu > 2) per_cu = 2;
    if (per_cu < 1) per_cu = 1;
    grid_blocks = cus * per_cu;
  }
  if (ws_size < WS_NEED) fprintf(stderr, "workspace too small: %zu < %zu\n", ws_size, (size_t)WS_NEED);
  Params p{};
  const float** f = (const float**)&p;
  for (int i = 0; i < 22; ++i) f[i] = (const float*)d_in[i];
  p.out = (float*)d_out; p.ws = (char*)d_ws;
#if MULTI_LAUNCH
#ifdef STOP_AT
  for (int ph = 0; ph < STOP_AT; ++ph) { p.lo = ph; p.hi = ph + 1; hipLaunchKernelGGL(fwd_kernel, dim3(grid_blocks), dim3(NTH), 0, stream, p); }
  hipLaunchKernelGGL(dump_kernel, dim3(TL * 1024 / 256), dim3(256), 0, stream, (const unsigned short*)d_ws, (float*)d_out, (size_t)WS_NEED / 2);
#else
  for (int ph = 0; ph < N_PHASES; ++ph) { p.lo = ph; p.hi = ph + 1; hipLaunchKernelGGL(fwd_kernel, dim3(grid_blocks), dim3(NTH), 0, stream, p); }
#endif
#else
  p.lo = 0; p.hi = N_PHASES;
  hipMemsetAsync((char*)d_ws + OFF_BAR, 0, 16384, stream);
  void* args[] = {&p};
  hipError_t e = hipLaunchCooperativeKernel((void*)fwd_kernel, dim3(grid_blocks), dim3(NTH), args, 0, stream);
  if (e != hipSuccess) fprintf(stderr, "cooperative launch failed: %s (grid %d)\n", hipGetErrorString(e), grid_blocks);
#endif
}
```

```cpp
#include <hip/hip_runtime.h>
#include <hip/hip_cooperative_groups.h>
#include <cstdio>
#include <cstdint>
namespace cg = cooperative_groups;

#ifndef MULTI_LAUNCH
#define MULTI_LAUNCH 0
#endif

typedef unsigned short bf16_t;
typedef short bf16x8 __attribute__((ext_vector_type(8)));
typedef short s16x4 __attribute__((ext_vector_type(4)));
typedef float f32x16 __attribute__((ext_vector_type(16)));
typedef float f32x4 __attribute__((ext_vector_type(4)));
typedef float f32x2 __attribute__((ext_vector_type(2)));
typedef unsigned u32x4 __attribute__((ext_vector_type(4)));
typedef unsigned u32x2 __attribute__((ext_vector_type(2)));
typedef __bf16 bf2_t __attribute__((ext_vector_type(2)));

#define DI __device__ __forceinline__
typedef __attribute__((address_space(3))) unsigned lds_u32_t;
#define GLDS(gp, lp) __builtin_amdgcn_global_load_lds((const unsigned*)(gp), (lds_u32_t*)(lp), 16, 0, 0)
#define MFMA(a, b, c) __builtin_amdgcn_mfma_f32_32x32x16_bf16((a), (b), (c), 0, 0, 0)

constexpr int T = 17408, TL = 16384, DM = 1024, NTH = 256;
constexpr float EPS = 1e-6f;
constexpr size_t SZ_U = (size_t)T * 1024 * 2;
constexpr size_t OFF_MOD = 0;
constexpr size_t OFF_TABR = OFF_MOD + 4 * 5 * 6144 * 4;
constexpr size_t OFF_TABD = OFF_TABR + 64 * 64 * 8;
constexpr size_t OFF_SSQ = OFF_TABD + 64 * 16 * 8;
constexpr size_t OFF_HC = OFF_SSQ + (size_t)T * 64 * 4 * 2;
constexpr size_t OFF_U = OFF_HC + 1024 * 1024 * 4;
constexpr size_t OFF_WM = OFF_U + SZ_U;
constexpr size_t OFF_WF = OFF_WM + (size_t)8192 * 1024 * 2 + (size_t)1024 * 2048 * 2;
constexpr size_t OFF_AR = OFF_WF + (size_t)5632 * 1024 * 2 + (size_t)1024 * 2816 * 2;
constexpr size_t OFF_BAR = OFF_AR + 9 * SZ_U;
constexpr size_t WS_NEED = OFF_BAR + 16384;

struct Params {
  const float *x, *c, *ctx, *c_ctx, *ada_w, *ada_b, *norm_g, *ret_w_in, *ret_w_out, *ret_df, *ret_db;
  const float *diff_w_in, *diff_w_out, *lq1, *lk1, *lq2, *lk2, *subln, *ffn_up, *ffn_cw, *ffn_cb, *ffn_down;
  float* out; char* ws; int lo, hi;
};

DI unsigned pk2(float lo, float hi) { f32x2 v = {lo, hi}; bf2_t b = __builtin_convertvector(v, bf2_t); return __builtin_bit_cast(unsigned, b); }
DI bf16_t f2bf(float x) { return (bf16_t)(pk2(x, 0.f) & 0xffffu); }
DI float bflo(unsigned u) { return __uint_as_float(u << 16); }
DI float bfhi(unsigned u) { return __uint_as_float(u & 0xffff0000u); }
DI float bf2f(bf16_t x) { return __uint_as_float((unsigned)x << 16); }
DI int crow(int reg, int h) { return (reg & 3) + 8 * (reg >> 2) + 4 * h; }
DI float ex2(float x) { return __builtin_amdgcn_exp2f(x); }
DI float wsum(float v) { for (int m = 32; m >= 1; m >>= 1) v += __shfl_xor(v, m); return v; }
DI float siluf(float x) { return x * __builtin_amdgcn_rcpf(1.f + __expf(-x)); }
DI bf16x8 pack8(const f32x16& x, int s) {
  u32x4 p; p.x = pk2(x[8 * s], x[8 * s + 1]); p.y = pk2(x[8 * s + 2], x[8 * s + 3]); p.z = pk2(x[8 * s + 4], x[8 * s + 5]); p.w = pk2(x[8 * s + 6], x[8 * s + 7]);
  return __builtin_bit_cast(bf16x8, p);
}
DI int lane_id() { return (int)__builtin_amdgcn_mbcnt_hi(~0u, __builtin_amdgcn_mbcnt_lo(~0u, 0u)); }
DI int otid_w(int wid_s) { int t = (wid_s << 6) | lane_id(); asm volatile("" : "+v"(t)); return t; }
#define otid() otid_w(wid_s)
DI f32x2 rope_cs(int pos, int fi, float cexp) {
  const float ang = (float)pos * ex2(-(float)fi * cexp);
  const float rev = ang * 0.15915494309189535f;
  const float fr = rev - rintf(rev);
  f32x2 cs; cs.x = __builtin_amdgcn_cosf(fr); cs.y = __builtin_amdgcn_sinf(fr); return cs;
}
#define XB_TMO      128
#define XB_XCNT(j)  (256  + 64 * (j))
#define XB_XSUB(j)  (1280 + 64 * (j))
#define XB_XGEN(j)  (2304 + 64 * (j))
#define XB_TOP      3328
#define XB_TOPGEN   3392
#define XB_SPIN_CAP (1u << 22)
#define LAS __attribute__((address_space(3)))
DI unsigned xb_ld(unsigned* p) { return __hip_atomic_load(p, __ATOMIC_RELAXED, __HIP_MEMORY_SCOPE_AGENT); }
DI unsigned xb_add(unsigned* p, unsigned v) { return __hip_atomic_fetch_add(p, v, __ATOMIC_RELAXED, __HIP_MEMORY_SCOPE_AGENT); }
DI unsigned xb_xcc_id() { return (unsigned)__builtin_amdgcn_s_getreg((3 << 11) | 20) & 0xFu; }
#define XB_SPIN(cond, bar) do { unsigned _sp = 0; while (cond) { __builtin_amdgcn_s_sleep(1); \
    if ((++_sp & 255u) == 0u) { if (xb_ld(&(bar)[XB_TMO])) break; if (_sp > XB_SPIN_CAP) { atomicAdd(&(bar)[XB_TMO], 1u); break; } } } } while (0)
struct XcdBarrier { unsigned* bar; unsigned x; volatile LAS unsigned* st; };
DI XcdBarrier xcd_barrier_post(unsigned* bar, volatile LAS unsigned* st, int wid_s) {
  XcdBarrier b; b.bar = bar; b.x = xb_xcc_id(); b.st = st;
  if (wid_s == 0 && lane_id() == 0) (void)xb_add(&bar[XB_XCNT(b.x)], 1u);
  return b;
}
DI void xcd_barrier_complete(unsigned* bar, unsigned x, unsigned& nloc, unsigned& nx) {
  const unsigned G = gridDim.x;
  unsigned sum, cnt, mine, sp = 0u;
  for (;;) {
    sum = 0u; cnt = 0u; mine = 0u;
#pragma unroll
    for (unsigned j = 0; j < 16; ++j) { const unsigned c = xb_ld(&bar[XB_XCNT(j)]); sum += c; cnt += (c > 0u) ? 1u : 0u; mine = (j == x) ? c : mine; }
    if (sum == G) break;
    __builtin_amdgcn_s_sleep(1);
    if ((++sp & 255u) == 0u) { if (xb_ld(&bar[XB_TMO])) break; if (sp > XB_SPIN_CAP) { atomicAdd(&bar[XB_TMO], 1u); break; } }
  }
  nloc = mine > 0u ? mine : 1u; nx = cnt > 0u ? cnt : 1u;
}
DI void xcd_barrier(const XcdBarrier& b, int wid_s) {
  asm volatile("s_waitcnt vmcnt(0)" ::: "memory");
  __syncthreads();
  if (wid_s == 0 && lane_id() == 0) {
    unsigned* bar = b.bar;
    __builtin_amdgcn_s_waitcnt(0);
    unsigned nloc = b.st[0], nx = b.st[1];
    if (nloc == 0u) { xcd_barrier_complete(bar, b.x, nloc, nx); b.st[0] = nloc; b.st[1] = nx; }
    const unsigned old = xb_add(&bar[XB_XSUB(b.x)], 1u);
    const unsigned gen = old / nloc;
    if (old + 1u == (gen + 1u) * nloc) {
      __builtin_amdgcn_fence(__ATOMIC_RELEASE, "agent");
      asm volatile("s_waitcnt vmcnt(0)" ::: "memory");
      const unsigned og = xb_add(&bar[XB_TOP], 1u);
      const unsigned tg = og / nx;
      if (og + 1u == (tg + 1u) * nx) xb_add(&bar[XB_TOPGEN], 1u);
      else XB_SPIN(xb_ld(&bar[XB_TOPGEN]) == tg, bar);
      __builtin_amdgcn_fence(__ATOMIC_ACQUIRE, "agent");
      xb_add(&bar[XB_XGEN(b.x)], 1u);
      asm volatile("s_waitcnt vmcnt(0)" ::: "memory");
    } else {
      XB_SPIN(xb_ld(&bar[XB_XGEN(b.x)]) == gen, bar);
      __builtin_amdgcn_fence(__ATOMIC_ACQUIRE, "agent");
      asm volatile("s_waitcnt vmcnt(0)" ::: "memory");
    }
  }
  __syncthreads();
}
template <int CTRL> DI float dpp_xadd(float x) { return x + __int_as_float(__builtin_amdgcn_update_dpp(0, __float_as_int(x), CTRL, 0xF, 0xF, true)); }
DI int rowbsel(int row) { return row < TL ? (row >> 12) : 4; }

DI int srccol(int g, int mode) {
  if (mode == 1) {
    if (g < 2048) return (g & ~127) + 32 * ((g >> 6) & 1) + (g & 31) + 64 * ((g >> 5) & 1);
    if (g < 4096) return g;
    int gp = g - 4096; return 4096 + 2048 * ((gp >> 5) & 1) + 32 * (gp >> 6) + (gp & 31);
  }
  if (mode == 2) {
    if (g < 2048) { int c = g & 31; return (g & ~63) + (c < 16 ? c : c + 16) + 16 * ((g >> 5) & 1); }
    return g;
  }
  if (mode == 3) return 64 * (g >> 7) + (g & 63) + 2816 * ((g >> 6) & 1);
  return g;
}
DI void conv_range(const float* __restrict__ src, int nsrc, bf16_t* __restrict__ dst, int K, int nrows, int mode, char* lds, int& base, int wid_s) {
  float (*tile)[65] = (float (*)[65])lds;
  const int tid = otid(), nkb = K >> 6, nitems = (nrows >> 6) * nkb, G = gridDim.x;
  int it = (int)((blockIdx.x + G - (base % G)) % G);
  float r[16];
  if (it < nitems) {
    const int g0 = (it / nkb) * 64, k0 = (it % nkb) * 64;
#pragma unroll
    for (int i = 0; i < 16; ++i) { int e = tid + 256 * i, kk = e >> 6, gg = e & 63; r[i] = src[(size_t)(k0 + kk) * nsrc + srccol(g0 + gg, mode)]; }
  }
  for (; it < nitems; it += G) {
    const int g0 = (it / nkb) * 64, k0 = (it % nkb) * 64;
#pragma unroll
    for (int i = 0; i < 16; ++i) { int e = tid + 256 * i, kk = e >> 6, gg = e & 63; tile[kk][gg] = r[i]; }
    __syncthreads();
    if (it + G < nitems) {
      const int g1 = ((it + G) / nkb) * 64, k1 = ((it + G) % nkb) * 64;
#pragma unroll
      for (int i = 0; i < 16; ++i) { int e = tid + 256 * i, kk = e >> 6, gg = e & 63; r[i] = src[(size_t)(k1 + kk) * nsrc + srccol(g1 + gg, mode)]; }
    }
    const int gg = tid >> 2, kq = (tid & 3) * 16;
    u32x4 w0, w1;
    w0.x = pk2(tile[kq + 0][gg], tile[kq + 1][gg]); w0.y = pk2(tile[kq + 2][gg], tile[kq + 3][gg]); w0.z = pk2(tile[kq + 4][gg], tile[kq + 5][gg]); w0.w = pk2(tile[kq + 6][gg], tile[kq + 7][gg]);
    w1.x = pk2(tile[kq + 8][gg], tile[kq + 9][gg]); w1.y = pk2(tile[kq + 10][gg], tile[kq + 11][gg]); w1.z = pk2(tile[kq + 12][gg], tile[kq + 13][gg]); w1.w = pk2(tile[kq + 14][gg], tile[kq + 15][gg]);
    bf16_t* d = dst + (size_t)(g0 + gg) * K + k0 + kq;
    *(u32x4*)d = w0; *(u32x4*)(d + 8) = w1;
    __syncthreads();
  }
  base += nitems;
}
DI void conv_mixer(const Params& P, int l, char* lds, int& base, int wid_s) {
  bf16_t* WM = (bf16_t*)(P.ws + OFF_WM); const int i = l >> 1;
  if ((l & 1) == 0) {
    conv_range(P.ret_w_in + (size_t)i * 1024 * 8192, 8192, WM, 1024, 8192, 1, lds, base, wid_s);
    conv_range(P.ret_w_out + (size_t)i * 2048 * 1024, 1024, WM + (size_t)8192 * 1024, 2048, 1024, 0, lds, base, wid_s);
  } else {
    conv_range(P.diff_w_in + (size_t)i * 1024 * 3072, 3072, WM, 1024, 3072, 2, lds, base, wid_s);
    conv_range(P.diff_w_out + (size_t)i * 1024 * 1024, 1024, WM + (size_t)3072 * 1024, 1024, 1024, 0, lds, base, wid_s);
  }
}
DI void conv_ffn(const Params& P, int l, char* lds, int& base, int wid_s) {
  bf16_t* WF = (bf16_t*)(P.ws + OFF_WF);
  conv_range(P.ffn_up + (size_t)l * 1024 * 5632, 5632, WF, 1024, 5632, 3, lds, base, wid_s);
  conv_range(P.ffn_down + (size_t)l * 2816 * 1024, 1024, WF + (size_t)5632 * 1024, 2816, 1024, 0, lds, base, wid_s);
}

DI void mod_phase(const Params& P, char* lds, int wid_s) {
  const int tid = otid();
  float* sc = (float*)lds; float* red = (float*)(lds + 20480);
  float* mod = (float*)(P.ws + OFF_MOD);
  for (int e = tid; e < 5120; e += NTH) { int bs = e >> 10, k = e & 1023; float v = bs < 4 ? P.c[bs * 1024 + k] : P.c_ctx[k]; sc[e] = v / (1.f + __expf(-v)); }
  __syncthreads();
  for (int item = blockIdx.x; item < 384; item += gridDim.x) {
    const int l = item / 96, cgp = item % 96, kq = tid >> 6, cl = tid & 63, col = cgp * 64 + cl;
    float a0 = 0, a1 = 0, a2 = 0, a3 = 0, a4 = 0;
    const float* w = P.ada_w + ((size_t)l * 1024 + kq * 256) * 6144 + col;
#pragma unroll 8
    for (int k = 0; k < 256; ++k) { float wv = w[(size_t)k * 6144]; int kk = kq * 256 + k; a0 += sc[kk] * wv; a1 += sc[1024 + kk] * wv; a2 += sc[2048 + kk] * wv; a3 += sc[3072 + kk] * wv; a4 += sc[4096 + kk] * wv; }
    red[(kq * 5 + 0) * 64 + cl] = a0; red[(kq * 5 + 1) * 64 + cl] = a1; red[(kq * 5 + 2) * 64 + cl] = a2; red[(kq * 5 + 3) * 64 + cl] = a3; red[(kq * 5 + 4) * 64 + cl] = a4;
    __syncthreads();
    for (int e = tid; e < 320; e += NTH) { int bs = e >> 6, c2 = e & 63; float s = red[(0 * 5 + bs) * 64 + c2] + red[(1 * 5 + bs) * 64 + c2] + red[(2 * 5 + bs) * 64 + c2] + red[(3 * 5 + bs) * 64 + c2];
      mod[(size_t)(l * 5 + bs) * 6144 + cgp * 64 + c2] = s + P.ada_b[l * 6144 + cgp * 64 + c2]; }
    __syncthreads();
  }
}

DI void pn_phase(const Params& P, int l_res, int which_res, int l_pre, int which_pre, bool h_from_input, const bf16_t* ybuf, int wid_s) {
  const int tid0 = otid(); const int lane = tid0 & 63, w = tid0 >> 6;
  const float* mod = (const float*)(P.ws + OFF_MOD);
  float* hc = (float*)(P.ws + OFF_HC); bf16_t* u = (bf16_t*)(P.ws + OFF_U);
  const int nrows = (l_pre < 0 || (l_res == 3 && which_res == 0)) ? TL : T;
  const int nw = gridDim.x * 4;
  for (int row0 = blockIdx.x * 4 + w; row0 < nrows; row0 += 2 * nw) {
    int rows[2] = {row0, row0 + nw};
    const bool has1 = rows[1] < nrows; if (!has1) rows[1] = row0;
    const float* hin[2]; float* hout[2]; int bs[2];
    f32x4 hv[2][4], yv[2][4];
#pragma unroll
    for (int k = 0; k < 2; ++k) {
      const int row = rows[k]; bs[k] = rowbsel(row);
      hin[k] = h_from_input ? (row < TL ? P.x + (size_t)row * 1024 : P.ctx + (size_t)(row - TL) * 1024)
                            : (row < TL ? P.out + (size_t)row * 1024 : hc + (size_t)(row - TL) * 1024);
      hout[k] = row < TL ? P.out + (size_t)row * 1024 : hc + (size_t)(row - TL) * 1024;
#pragma unroll
      for (int i = 0; i < 4; ++i) hv[k][i] = *(const f32x4*)(hin[k] + lane * 4 + 256 * i);
      if (l_res >= 0) {
#pragma unroll
        for (int i = 0; i < 4; ++i) {
          if (row < TL) { const u32x2 yr = *(const u32x2*)(ybuf + (size_t)row * 1024 + lane * 4 + 256 * i); yv[k][i] = (f32x4){bflo(yr.x), bfhi(yr.x), bflo(yr.y), bfhi(yr.y)}; }
          else {
            const float* yp = (const float*)(P.ws + OFF_AR + 4 * SZ_U) + (size_t)(row - TL) * 1024 + lane * 4 + 256 * i;
            yv[k][i] = (*(const f32x4*)yp + *(const f32x4*)(yp + 1024 * 1024)) + (*(const f32x4*)(yp + 2 * 1024 * 1024) + *(const f32x4*)(yp + 3 * 1024 * 1024));
          }
        }
      }
    }
#pragma unroll
    for (int k = 0; k < 2; ++k) {
      if (k == 1 && !has1) break;
      const int row = rows[k];
      if (l_res >= 0) {
        float ss = 0.f;
#pragma unroll
        for (int i = 0; i < 4; ++i) ss += yv[k][i].x * yv[k][i].x + yv[k][i].y * yv[k][i].y + yv[k][i].z * yv[k][i].z + yv[k][i].w * yv[k][i].w;
        ss = wsum(ss); const float rstd = rsqrtf(ss * (1.f / 1024.f) + EPS);
        const float* gate = mod + (size_t)(l_res * 5 + bs[k]) * 6144 + (which_res ? 5 : 2) * 1024;
        const float* gp = P.norm_g + (size_t)(l_res * 4 + (which_res ? 3 : 1)) * 1024;
#pragma unroll
        for (int i = 0; i < 4; ++i) { f32x4 gt = *(const f32x4*)(gate + lane * 4 + 256 * i), gg = *(const f32x4*)(gp + lane * 4 + 256 * i); hv[k][i] += gt * (yv[k][i] * rstd * gg); *(f32x4*)(hout[k] + lane * 4 + 256 * i) = hv[k][i]; }
      }
      if (l_pre >= 0) {
        float ss = 0.f;
#pragma unroll
        for (int i = 0; i < 4; ++i) ss += hv[k][i].x * hv[k][i].x + hv[k][i].y * hv[k][i].y + hv[k][i].z * hv[k][i].z + hv[k][i].w * hv[k][i].w;
        ss = wsum(ss); const float rstd = rsqrtf(ss * (1.f / 1024.f) + EPS);
        const float* g = P.norm_g + (size_t)(l_pre * 4 + (which_pre ? 2 : 0)) * 1024;
        const float* sh = mod + (size_t)(l_pre * 5 + bs[k]) * 6144 + (which_pre ? 3 : 0) * 1024;
        const float* scv = mod + (size_t)(l_pre * 5 + bs[k]) * 6144 + (which_pre ? 4 : 1) * 1024;
#pragma unroll
        for (int i = 0; i < 4; ++i) {
          f32x4 gg = *(const f32x4*)(g + lane * 4 + 256 * i), s1 = *(const f32x4*)(sh + lane * 4 + 256 * i), s2 = *(const f32x4*)(scv + lane * 4 + 256 * i);
          f32x4 o = (hv[k][i] * rstd * gg) * (s2 + 1.f) + s1;
          u32x2 pk; pk.x = pk2(o.x, o.y); pk.y = pk2(o.z, o.w);
          *(u32x2*)(u + (size_t)row * 1024 + lane * 4 + 256 * i) = pk;
        }
      }
    }
  }
}

DI void act_phase(const Params& P, int l, int wid_s) {
  const bf16_t* __restrict__ vg = (const bf16_t*)(P.ws + OFF_AR); bf16_t* __restrict__ a = (bf16_t*)(P.ws + OFF_AR + 6 * SZ_U);
  const float* cw = P.ffn_cw + (size_t)l * 3 * 2816; const float* cb = P.ffn_cb + (size_t)l * 2816;
  const int tid = otid();
  for (int item = blockIdx.x; item < 272 * 352 / 256; item += gridDim.x) {
    const int u = item * 256 + tid; const int br = u / 352, ch = u - br * 352;
    const int r = (br >> 1) * 128 + (br & 1) * 127;
    const int p = r < TL ? (r & 4095) : ((r - TL) & 255); const int slen = r < TL ? 4096 : 256;
    const int f0 = ch * 8;
    const bf16_t* gp = vg + (size_t)r * 5632 + 2816 + f0;
    u32x4 g0 = {0, 0, 0, 0}, g2 = {0, 0, 0, 0};
    if (p != 0) g0 = *(const u32x4*)(gp - 5632);
    if (p + 1 < slen) g2 = *(const u32x4*)(gp + 5632);
    const u32x4 g1 = *(const u32x4*)gp, vv = *(const u32x4*)(vg + (size_t)r * 5632 + f0);
    float o[8];
#pragma unroll
    for (int qd = 0; qd < 4; ++qd) {
      const float x0 = cw[f0 + 2 * qd] * bflo(g0[qd]) + cw[2816 + f0 + 2 * qd] * bflo(g1[qd]) + cw[5632 + f0 + 2 * qd] * bflo(g2[qd]) + cb[f0 + 2 * qd];
      const float x1 = cw[f0 + 2 * qd + 1] * bfhi(g0[qd]) + cw[2816 + f0 + 2 * qd + 1] * bfhi(g1[qd]) + cw[5632 + f0 + 2 * qd + 1] * bfhi(g2[qd]) + cb[f0 + 2 * qd + 1];
      o[2 * qd] = siluf(x0) * bflo(vv[qd]); o[2 * qd + 1] = siluf(x1) * bfhi(vv[qd]);
    }
    u32x4 ov; ov.x = pk2(o[0], o[1]); ov.y = pk2(o[2], o[3]); ov.z = pk2(o[4], o[5]); ov.w = pk2(o[6], o[7]);
    *(u32x4*)(a + (size_t)r * 2816 + f0) = ov;
  }
}

enum { EPI_F32 = 0, EPI_BF16 = 1, EPI_ROPE_RET_N = 2, EPI_ROPE_RET_T = 3, EPI_ROPE_DIFF_N = 4, EPI_MERGE = 5, EPI_SMASK = 6, EPI_ACT = 7 };
struct Job { const bf16_t* A; const bf16_t* B; int lda, ldb, K, m0, n0, epi, ldc, aux, afrag; void* out; float scale; };

DI void gemm_tile(const Params& P, const Job& J, char* lds, int tid) {
  const int lane = tid & 63, w = tid >> 6, wm = w >> 1, wn = w & 1, l31 = lane & 31, hi = lane >> 5;
  f32x16 acc[2][2];
#pragma unroll
  for (int a = 0; a < 2; ++a)
#pragma unroll
    for (int b = 0; b < 2; ++b)
#pragma unroll
      for (int r = 0; r < 16; ++r) acc[a][b][r] = 0.f;
  const int lrow = tid >> 3, lkc = (tid & 7) ^ ((tid >> 4) & 7);
  const bf16_t* ga = J.afrag ? J.A + ((((size_t)(J.m0 >> 5) * 4 + (J.afrag - 1)) * 16 + (lkc >> 1)) * 64 + (lkc & 1) * 32 + lrow) * 8
                             : J.A + (size_t)(J.m0 + lrow) * J.lda + lkc * 8;
  const bf16_t* gb = J.B + (size_t)(J.n0 + lrow) * J.ldb + lkc * 8;
  const size_t sa = J.afrag ? (size_t)32768 : (size_t)32 * J.lda, sb = (size_t)32 * J.ldb;
  const size_t ksa = J.afrag ? 2048 : 64;
  const int swz = (lane >> 1) & 7;
  const int aoff = (64 * wm + l31) * 128, boff = 16384 + (64 * wn + l31) * 128;
  const int nk = J.K >> 6;
  char* wbase = lds + tid * 16;
#pragma unroll
  for (int i = 0; i < 4; ++i) { GLDS(ga + i * sa, wbase + i * 4096); GLDS(gb + i * sb, wbase + 16384 + i * 4096); }
  asm volatile("s_waitcnt vmcnt(0)" ::: "memory");
  __syncthreads();
  for (int kt = 0; kt < nk; ++kt) {
    const char* cur = lds + (kt & 1) * 32768; char* nxt = wbase + ((kt + 1) & 1) * 32768;
    if (kt + 1 < nk) {
#pragma unroll
      for (int i = 0; i < 4; ++i) { GLDS(ga + (size_t)(kt + 1) * ksa + i * sa, nxt + i * 4096); GLDS(gb + (size_t)(kt + 1) * 64 + i * sb, nxt + 16384 + i * 4096); }
    }
    bf16x8 fa[2][2], fb[2][2];
    { const int ko = ((0 + hi) ^ swz) << 4;
      fa[0][0] = *(const bf16x8*)(cur + aoff + ko); fa[0][1] = *(const bf16x8*)(cur + aoff + 4096 + ko);
      fb[0][0] = *(const bf16x8*)(cur + boff + ko); fb[0][1] = *(const bf16x8*)(cur + boff + 4096 + ko); }
#pragma unroll
    for (int s = 0; s < 4; ++s) {
      const int c = s & 1, n = c ^ 1;
      if (s < 3) {
        const int ko = ((2 * (s + 1) + hi) ^ swz) << 4;
        fa[n][0] = *(const bf16x8*)(cur + aoff + ko); fa[n][1] = *(const bf16x8*)(cur + aoff + 4096 + ko);
        fb[n][0] = *(const bf16x8*)(cur + boff + ko); fb[n][1] = *(const bf16x8*)(cur + boff + 4096 + ko);
      }
      acc[0][0] = MFMA(fa[c][0], fb[c][0], acc[0][0]); acc[0][1] = MFMA(fa[c][0], fb[c][1], acc[0][1]);
      acc[1][0] = MFMA(fa[c][1], fb[c][0], acc[1][0]); acc[1][1] = MFMA(fa[c][1], fb[c][1], acc[1][1]);
      __builtin_amdgcn_sched_barrier(0);
    }
    asm volatile("s_waitcnt vmcnt(0)" ::: "memory");
    __syncthreads();
  }
  int l31e = l31, hie = hi; asm volatile("" : "+v"(l31e), "+v"(hie));
  const int m0w = J.m0 + 64 * wm, n0w = J.n0 + 64 * wn;
  if (J.epi == EPI_F32) {
    float* o = (float*)J.out;
#pragma unroll
    for (int tm = 0; tm < 2; ++tm)
#pragma unroll
      for (int tn = 0; tn < 2; ++tn)
#pragma unroll
        for (int r = 0; r < 16; ++r) o[(size_t)(m0w + 32 * tm + crow(r, hie)) * J.ldc + n0w + 32 * tn + l31e] = acc[tm][tn][r];
    return;
  }
  constexpr int IST = 272;
  char* img = lds;
  bf16_t* obase; size_t oldc; int ocols = 128, ist = IST;
  if (J.epi == EPI_BF16) {
#pragma unroll
    for (int tm = 0; tm < 2; ++tm)
#pragma unroll
      for (int tn = 0; tn < 2; ++tn)
#pragma unroll
        for (int r = 0; r < 16; ++r) {
          int cl = 64 * wn + 32 * tn + l31e;
          if (J.aux & 1) cl = (cl & ~12) | ((cl & 4) << 1) | ((cl & 8) >> 1);
          *(bf16_t*)(img + (64 * wm + 32 * tm + crow(r, hie)) * IST + cl * 2) = f2bf(acc[tm][tn][r]);
        }
    obase = (bf16_t*)J.out + (size_t)J.m0 * J.ldc + J.n0; oldc = J.ldc;
  } else if (J.epi == EPI_ROPE_RET_N) {
    const int g128 = n0w >> 7, fi = 32 * wn + l31e;
#pragma unroll
    for (int tm = 0; tm < 2; ++tm)
#pragma unroll
      for (int r = 0; r < 16; ++r) {
        const int rl = 64 * wm + 32 * tm + crow(r, hie), row = J.m0 + rl;
        float x1 = acc[tm][0][r], x2 = acc[tm][1][r];
        if (row < TL) { const int pos = (g128 & 1) ? (row & 63) : ((row >> 6) & 63); const f32x2 cs = rope_cs(pos, fi, 13.287712379549449f / 64.f); const float y1 = x1 * cs.x - x2 * cs.y, y2 = x1 * cs.y + x2 * cs.x; x1 = y1; x2 = y2; }
        *(bf16_t*)(img + rl * IST + fi * 2) = f2bf(x1 * J.scale); *(bf16_t*)(img + rl * IST + (fi + 64) * 2) = f2bf(x2 * J.scale);
      }
    obase = (bf16_t*)J.out + (size_t)J.m0 * 1024 + J.n0; oldc = 1024;
  } else if (J.epi == EPI_ROPE_RET_T) {
    const int g128 = m0w >> 7;
#pragma unroll
    for (int tn = 0; tn < 2; ++tn) {
      const int cl = 64 * wn + 32 * tn + l31e, tok = J.n0 + cl; const int pos = (g128 & 1) ? (tok & 63) : ((tok >> 6) & 63);
#pragma unroll
      for (int r = 0; r < 16; ++r) {
        const int fi = 32 * wm + crow(r, hie);
        float x1 = acc[0][tn][r], x2 = acc[1][tn][r];
        if (tok < TL) { const f32x2 cs = rope_cs(pos, fi, 13.287712379549449f / 64.f); const float y1 = x1 * cs.x - x2 * cs.y, y2 = x1 * cs.y + x2 * cs.x; x1 = y1; x2 = y2; }
        *(bf16_t*)(img + fi * IST + cl * 2) = f2bf(x1 * J.scale); *(bf16_t*)(img + (fi + 64) * IST + cl * 2) = f2bf(x2 * J.scale);
      }
    }
    obase = (bf16_t*)J.out + (size_t)J.m0 * T + J.n0; oldc = T;
  } else if (J.epi == EPI_ROPE_DIFF_N) {
    const int fi = l31e & 15, c1 = 64 * wn + (l31e < 16 ? l31e : l31e + 16);
#pragma unroll
    for (int tm = 0; tm < 2; ++tm)
#pragma unroll
      for (int r = 0; r < 16; ++r) {
        const int rl = 64 * wm + 32 * tm + crow(r, hie), row = J.m0 + rl;
        float x1 = acc[tm][0][r], x2 = acc[tm][1][r];
        if (row < TL) { const int pos = (l31e < 16) ? ((row >> 6) & 63) : (row & 63); const f32x2 cs = rope_cs(pos, fi, 13.287712379549449f / 16.f); const float y1 = x1 * cs.x - x2 * cs.y, y2 = x1 * cs.y + x2 * cs.x; x1 = y1; x2 = y2; }
        *(bf16_t*)(img + rl * IST + c1 * 2) = f2bf(x1); *(bf16_t*)(img + rl * IST + (c1 + 16) * 2) = f2bf(x2);
      }
    obase = (bf16_t*)J.out + (size_t)J.m0 * 1024 + J.n0; oldc = 1024;
  } else if (J.epi == EPI_SMASK) {
    const int il4 = J.aux, hh = il4 & 3;
    const float lgf = -log2f(1.f + expf(-P.ret_df[il4])), lgb = -log2f(1.f + expf(-P.ret_db[il4]));
#pragma unroll
    for (int d = 0; d < 2; ++d) {
#pragma unroll
      for (int tm = 0; tm < 2; ++tm)
#pragma unroll
        for (int tn = 0; tn < 2; ++tn)
#pragma unroll
          for (int r = 0; r < 16; ++r) {
            const int i = 64 * wm + 32 * tm + crow(r, hie), j = 64 * wn + 32 * tn + l31e, dd = d ? j - i : i - j;
            const float v = dd >= 0 ? acc[tm][tn][r] * ex2((d ? lgb : lgf) * (float)dd) : 0.f;
            *(bf16_t*)(img + i * IST + j * 2) = f2bf(v);
          }
      __syncthreads();
      bf16_t* ob2 = (bf16_t*)J.out + (size_t)J.m0 * 1024 + hh * 256 + d * 128;
#pragma unroll
      for (int i = 0; i < 8; ++i) { const int c = tid + 256 * i, row = c >> 4, cc = c & 15, hb = ((d * 4 + (row >> 5)) * 8 + (cc >> 1)) * 2 + (cc & 1);
        *(u32x4*)((bf16_t*)J.out + (size_t)(J.m0 + hb) * 1024 + hh * 256 + (row & 31) * 8) = *(const u32x4*)(img + row * IST + cc * 16); }
      __syncthreads();
    }
    return;
  } else if (J.epi == EPI_ACT) {
#pragma unroll
    for (int tm = 0; tm < 2; ++tm)
#pragma unroll
      for (int tn = 0; tn < 2; ++tn)
#pragma unroll
        for (int r = 0; r < 16; ++r) *(bf16_t*)(img + (64 * wm + 32 * tm + crow(r, hie)) * IST + (64 * wn + 32 * tn + l31e) * 2) = f2bf(acc[tm][tn][r]);
    __syncthreads();
    {
      const int ch = tid & 7, rg = tid >> 3, f0 = 64 * (J.n0 >> 7) + 8 * ch;
      const float* cw = P.ffn_cw + (size_t)J.aux * 3 * 2816; const float* cb = P.ffn_cb + (size_t)J.aux * 2816;
      float w0[8], w1[8], w2[8], bb[8];
#pragma unroll
      for (int j = 0; j < 8; ++j) { w0[j] = cw[f0 + j]; w1[j] = cw[2816 + f0 + j]; w2[j] = cw[5632 + f0 + j]; bb[j] = cb[f0 + j]; }
      const int slen = J.m0 < TL ? 4096 : 256, p0 = J.m0 < TL ? (J.m0 & 4095) : ((J.m0 - TL) & 255);
      const bool sstart = p0 == 0, send = p0 + 128 == slen;
      u32x4 g[6], vv[4];
#pragma unroll
      for (int qd = 0; qd < 6; ++qd) { const int lr = 4 * rg - 1 + qd; g[qd] = (u32x4){0, 0, 0, 0}; if (lr >= 0 && lr < 128) g[qd] = *(const u32x4*)(img + lr * IST + (64 + 8 * ch) * 2); }
#pragma unroll
      for (int qd = 0; qd < 4; ++qd) vv[qd] = *(const u32x4*)(img + (4 * rg + qd) * IST + 8 * ch * 2);
      bf16_t* aout = (bf16_t*)J.out; bf16_t* vgb = (bf16_t*)(P.ws + OFF_AR);
#pragma unroll
      for (int qd = 0; qd < 4; ++qd) {
        const int lr = 4 * rg + qd;
        float o[8];
#pragma unroll
        for (int k2 = 0; k2 < 4; ++k2) {
          const float x0 = w0[2 * k2] * bflo(g[qd][k2]) + w1[2 * k2] * bflo(g[qd + 1][k2]) + w2[2 * k2] * bflo(g[qd + 2][k2]) + bb[2 * k2];
          const float x1 = w0[2 * k2 + 1] * bfhi(g[qd][k2]) + w1[2 * k2 + 1] * bfhi(g[qd + 1][k2]) + w2[2 * k2 + 1] * bfhi(g[qd + 2][k2]) + bb[2 * k2 + 1];
          o[2 * k2] = siluf(x0) * bflo(vv[qd][k2]); o[2 * k2 + 1] = siluf(x1) * bfhi(vv[qd][k2]);
        }
        if ((lr > 0 || sstart) && (lr < 127 || send)) {
          u32x4 ov; ov.x = pk2(o[0], o[1]); ov.y = pk2(o[2], o[3]); ov.z = pk2(o[4], o[5]); ov.w = pk2(o[6], o[7]);
          *(u32x4*)(aout + (size_t)(J.m0 + lr) * 2816 + f0) = ov;
        }
        if (lr < 2 || lr > 125) {
          *(u32x4*)(vgb + (size_t)(J.m0 + lr) * 5632 + f0) = vv[qd];
          *(u32x4*)(vgb + (size_t)(J.m0 + lr) * 5632 + 2816 + f0) = g[qd + 1];
        }
      }
    }
    __syncthreads();
    return;
  } else {
    constexpr int MST = 144;
    char* oft = lds + 18432; char* obt = lds + 36864; float* rs = (float*)(lds + 55296);
    const int f0 = J.n0 >> 1, hd = f0 >> 9;
    const bf16_t* of = (const bf16_t*)(P.ws + OFF_AR + 5 * SZ_U); const bf16_t* ob = (const bf16_t*)(P.ws + OFF_AR + 7 * SZ_U);
    {
      const int row = tid & 127, dir = tid >> 7;
      const float* sp = (const float*)(P.ws + OFF_SSQ) + (dir ? (size_t)T * 64 : 0) + ((size_t)(J.m0 + row) * 4 + hd) * 16;
      float sm = 0.f;
#pragma unroll
      for (int qd = 0; qd < 4; ++qd) { const f32x4 pv = *(const f32x4*)(sp + 4 * qd); sm += (pv.x + pv.y) + (pv.z + pv.w); }
      rs[tid] = rsqrtf(sm * (1.f / 512.f) + EPS);
#pragma unroll
      for (int i = 0; i < 4; ++i) {
        const int c = tid + 256 * i, r2 = c >> 3, cc = c & 7;
        *(u32x4*)(oft + r2 * MST + cc * 16) = *(const u32x4*)(of + (size_t)(J.m0 + r2) * 2048 + f0 + cc * 8);
        *(u32x4*)(obt + r2 * MST + cc * 16) = *(const u32x4*)(ob + (size_t)(J.m0 + r2) * 2048 + f0 + cc * 8);
      }
    }
    __syncthreads();
    const int cl = 32 * wn + l31e;
#pragma unroll
    for (int tm = 0; tm < 2; ++tm)
#pragma unroll
      for (int r = 0; r < 16; ++r) {
        const int rl = 64 * wm + 32 * tm + crow(r, hie);
        const float vf = bf2f(*(const bf16_t*)(oft + rl * MST + cl * 2)) * rs[rl], vb = bf2f(*(const bf16_t*)(obt + rl * MST + cl * 2)) * rs[128 + rl];
        *(bf16_t*)(img + rl * MST + cl * 2) = f2bf(siluf(acc[tm][0][r]) * vf + siluf(acc[tm][1][r]) * vb);
      }
    obase = (bf16_t*)J.out + (size_t)J.m0 * 2048 + f0; oldc = 2048; ocols = 64; ist = MST;
  }
  __syncthreads();
  if (ocols == 128 && (J.aux & 2)) {
    const int ci = J.n0 >> 7;
#pragma unroll
    for (int i = 0; i < 8; ++i) {
      const int c = tid + 256 * i, row = c >> 4, cc = c & 15, gt = (J.m0 + row) >> 5;
      bf16_t* dst = (bf16_t*)J.out + ((((size_t)gt * 136 + ci) * 8 + (cc >> 1)) * 64 + (cc & 1) * 32 + (row & 31)) * 8;
      *(u32x4*)dst = *(const u32x4*)(img + row * ist + cc * 16);
    }
  } else if (ocols == 128 && (J.aux & 8)) {
    const int hq = J.n0 >> 8, s0 = ((J.n0 >> 7) & 1) * 8;
#pragma unroll
    for (int i = 0; i < 8; ++i) {
      const int c = tid + 256 * i, row = c >> 4, cc = c & 15, rt = (J.m0 + row) >> 5;
      bf16_t* dst = (bf16_t*)J.out + ((((size_t)rt * 4 + hq) * 16 + s0 + (cc >> 1)) * 64 + (cc & 1) * 32 + (row & 31)) * 8;
      *(u32x4*)dst = *(const u32x4*)(img + row * ist + cc * 16);
    }
  } else if (ocols == 128) {
#pragma unroll
    for (int i = 0; i < 8; ++i) { const int c = tid + 256 * i, row = c >> 4, cc = c & 15; *(u32x4*)(obase + (size_t)row * oldc + cc * 8) = *(const u32x4*)(img + row * ist + cc * 16); }
  } else {
#pragma unroll
    for (int i = 0; i < 4; ++i) { const int c = tid + 256 * i, row = c >> 3, cc = c & 7; *(u32x4*)(obase + (size_t)row * oldc + cc * 8) = *(const u32x4*)(img + row * ist + cc * 16); }
  }
  if (J.aux & 32) {
    bf16_t* ktf = (bf16_t*)(P.ws + OFF_AR + 2 * SZ_U);
    const int ci = J.m0 >> 7;
#pragma unroll
    for (int i = 0; i < 8; ++i) {
      const int c = tid + 256 * i, dl = c & 127, jc = c >> 7;
      const char* src = img + (8 * jc) * ist + dl * 2;
      u32x4 v;
      v.x = (unsigned)*(const bf16_t*)(src) | ((unsigned)*(const bf16_t*)(src + ist) << 16);
      v.y = (unsigned)*(const bf16_t*)(src + 2 * ist) | ((unsigned)*(const bf16_t*)(src + 3 * ist) << 16);
      v.z = (unsigned)*(const bf16_t*)(src + 4 * ist) | ((unsigned)*(const bf16_t*)(src + 5 * ist) << 16);
      v.w = (unsigned)*(const bf16_t*)(src + 6 * ist) | ((unsigned)*(const bf16_t*)(src + 7 * ist) << 16);
      bf16_t* dst = ktf + (((((size_t)((J.n0 + dl) >> 5) * 136 + ci) * 8 + (jc >> 1)) * 64) + (jc & 1) * 32 + (dl & 31)) * 8;
      *(u32x4*)dst = v;
    }
  }
  __syncthreads();
}

DI void tile_mn(int idx, int nN, int& tm, int& tn) { const int per = 8 * nN, mg = idx / per, rem = idx % per; tn = rem >> 3; tm = mg * 8 + (rem & 7); }

enum { GP_RET_IN = 0, GP_RET_GATE, GP_RET_OUT, GP_DIFF_IN, GP_DIFF_OUT, GP_FFN_UP, GP_FFN_DOWN, GP_RET_S };
DI void gemm_phase(const Params& P, int kind, char* lds, int layer, int wid_s) {
  const bf16_t* U = (const bf16_t*)(P.ws + OFF_U); const bf16_t* WM = (const bf16_t*)(P.ws + OFF_WM); const bf16_t* WF = (const bf16_t*)(P.ws + OFF_WF);
  char* AR = P.ws + OFF_AR;
  int total;
  switch (kind) {
    case GP_RET_IN: total = 1088 * 4; break;
    case GP_RET_S: total = 544; break;
    case GP_RET_GATE: total = 136 * 32; break;
    case GP_DIFF_IN: total = 1088 * 3; break;
    case GP_FFN_UP: total = (layer == 3 ? 128 : 136) * 44; break;
    default: total = layer == 3 ? 1024 : 1024 + 256; break;
  }
  const int G = gridDim.x, per = G >> 3; const int tid = otid();
  for (int base = 0; base < total; base += G) {
    int L = base + ((G & 7) == 0 ? (int)(blockIdx.x & 7) * per + (int)(blockIdx.x >> 3) : (int)blockIdx.x);
    if (L >= total) continue;
    Job J; J.lda = 1024; J.ldb = 1024; J.K = 1024; J.scale = 1.f; J.ldc = 1024; J.aux = 0; J.afrag = 0;
    int tm, tn;
    if (kind == GP_RET_S) { const int hh = L & 3, ci = L >> 2; tm = ci; tn = ci; J.A = (const bf16_t*)AR; J.afrag = 1 + hh; J.B = (const bf16_t*)(AR + SZ_U) + hh * 256; J.K = 256; J.epi = EPI_SMASK; J.out = AR + SZ_U; J.aux = (layer >> 1) * 4 + hh; }
    else if (kind == GP_RET_IN) {
      if (L < 1088) { tile_mn(L, 8, tm, tn); J.A = U; J.B = WM; J.epi = EPI_ROPE_RET_N; J.out = AR; J.aux = 8; }
      else if (L < 2176) { tile_mn(L - 1088, 8, tm, tn); J.A = U; J.B = WM + (size_t)1024 * 1024; J.epi = EPI_ROPE_RET_N; J.out = AR + SZ_U; J.scale = 0.0625f; J.aux = 32; }
      else { tile_mn(L - 2176, 136, tm, tn); J.A = WM + (size_t)2048 * 1024; J.B = U; J.epi = EPI_BF16; J.out = AR + 3 * SZ_U; J.ldc = T; J.aux = 2; }
    } else if (kind == GP_RET_GATE) { tile_mn(L, 32, tm, tn); J.A = U; J.B = WM + (size_t)4096 * 1024; J.epi = EPI_MERGE; J.out = AR; }
    else if (kind == GP_RET_OUT) { tile_mn(L < 1024 ? L : 1024 + ((L - 1024) >> 2), 8, tm, tn); J.A = (const bf16_t*)AR; J.lda = 2048; J.B = WM + (size_t)8192 * 1024; J.ldb = 2048; J.K = 2048; J.epi = EPI_BF16; J.out = AR + 3 * SZ_U; }
    else if (kind == GP_DIFF_IN) {
      if (L < 1088) { tile_mn(L, 8, tm, tn); J.A = U; J.B = WM; J.epi = EPI_ROPE_DIFF_N; J.out = AR; }
      else if (L < 2176) { tile_mn(L - 1088, 8, tm, tn); J.A = U; J.B = WM + (size_t)1024 * 1024; J.epi = EPI_ROPE_DIFF_N; J.out = AR + SZ_U; }
      else { tile_mn(L - 2176, 136, tm, tn); J.A = WM + (size_t)2048 * 1024; J.B = U; J.epi = EPI_BF16; J.out = AR + 2 * SZ_U; J.ldc = T; J.aux = 1; }
    } else if (kind == GP_DIFF_OUT) { tile_mn(L < 1024 ? L : 1024 + ((L - 1024) >> 2), 8, tm, tn); J.A = (const bf16_t*)(AR + 5 * SZ_U); J.B = WM + (size_t)3072 * 1024; J.epi = EPI_BF16; J.out = AR + 3 * SZ_U; }
    else if (kind == GP_FFN_UP) { tile_mn(L, 44, tm, tn); J.A = U; J.B = WF; J.epi = EPI_ACT; J.out = AR + 6 * SZ_U; J.aux = layer; }
    else { tile_mn(L < 1024 ? L : 1024 + ((L - 1024) >> 2), 8, tm, tn); J.A = (const bf16_t*)(AR + 6 * SZ_U); J.lda = 2816; J.B = WF + (size_t)5632 * 1024; J.ldb = 2816; J.K = 2816; J.epi = EPI_BF16; J.out = AR; }
    if ((kind == GP_RET_OUT || kind == GP_DIFF_OUT || kind == GP_FFN_DOWN) && L >= 1024) {
      const int kp = (L - 1024) & 3, kq = J.K >> 2;
      J.A += kp * kq; J.B += kp * kq; J.K = kq; J.epi = EPI_F32; J.ldc = 1024;
      J.out = (float*)(AR + 4 * SZ_U) + (size_t)kp * 1024 * 1024 - (size_t)TL * 1024;
    }
    J.m0 = tm * 128; J.n0 = tn * 128;
    gemm_tile(P, J, lds, tid);
  }
}

DI void write_rt(const f32x16 (&accR)[2], char* lds, int w, int l31, int hi) {
#pragma unroll
  for (int td = 0; td < 2; ++td)
#pragma unroll
    for (int g = 0; g < 4; ++g) {
      const int d = 64 * w + 32 * td + 8 * g + 4 * hi, v = l31;
      u32x2 pk; pk.x = pk2(accR[td][4 * g], accR[td][4 * g + 1]); pk.y = pk2(accR[td][4 * g + 2], accR[td][4 * g + 3]);
      *(u32x2*)(lds + v * 512 + (((d >> 3) ^ (v & 15)) << 4) + (d & 7) * 2) = pk;
    }
}
DI int ret_r0(int cc, int dir, int b) { return cc < 2 ? TL + b * 256 + 128 * (dir ? 1 - cc : cc) : b * 4096 + 128 * (dir ? 33 - cc : cc - 2); }
DI void ret_phase(const Params& P, int l, char* lds, int wid_s) {
  const int tid = otid(), lane = tid & 63, w = tid >> 6, l31 = lane & 31, hi = lane >> 5, il = l >> 1;
  const char* q = P.ws + OFF_AR; const char* pd = P.ws + OFF_AR + SZ_U;
  const char* kT = P.ws + OFF_AR + 2 * SZ_U; const char* vT = P.ws + OFF_AR + 3 * SZ_U;
  for (int item = blockIdx.x; item < 512; item += gridDim.x) {
    const int dvs = item & 15, dir = (item >> 4) & 1, hh = (item >> 5) & 3, b = item >> 7;
    const float logit = (dir ? P.ret_db : P.ret_df)[il * 4 + hh];
    const float l2g = -log2f(1.f + expf(-logit));
    const float cdec = ex2(l2g * 128.f);
    const float gstep = ex2(dir ? l2g : -l2g);
    char* obuf = P.ws + OFF_AR + (dir ? 7 : 5) * SZ_U;
    float* ssq = (float*)(P.ws + OFF_SSQ) + (dir ? (size_t)T * 64 : 0);
    f32x16 accR[2];
#pragma unroll
    for (int a = 0; a < 2; ++a)
#pragma unroll
      for (int r = 0; r < 16; ++r) accR[a][r] = 0.f;
    __syncthreads();
    write_rt(accR, lds, w, l31, hi);
    __syncthreads();
    bf16x8 pa[8], bv[8], bq[16];
    {
      const int r0 = ret_r0(0, dir, b);
      const unsigned po = (unsigned)((((((r0 >> 5) + w) * 4 + hh) * 16) * 64) + lane) * 16u;
      const unsigned pf = (unsigned)((r0 + (dir * 4 + w) * 16 + hi) * 1024 + hh * 256 + l31 * 8) * 2u;
      const unsigned vo = (unsigned)((((hh * 16 + dvs) * 136 + (r0 >> 7)) * 8) * 64 + lane) * 16u;
#pragma unroll
      for (int s = 0; s < 8; ++s) { pa[s] = *(const bf16x8*)(pd + (pf + 4096u * s)); bv[s] = *(const bf16x8*)(vT + (vo + 1024u * s)); }
#pragma unroll
      for (int s = 0; s < 16; ++s) bq[s] = *(const bf16x8*)(q + (po + 1024u * s));
    }
    for (int cc = 0; cc < 34; ++cc) {
      float lg = l2g; int hiv = hi, l31v = l31; asm volatile("" : "+v"(lg), "+v"(hiv), "+v"(l31v));
      const int r0 = ret_r0(cc, dir, b);
      f32x16 accO, accQ;
#pragma unroll
      for (int r = 0; r < 16; ++r) { accO[r] = 0.f; accQ[r] = 0.f; }
#pragma unroll
      for (int s = 0; s < 8; ++s) accO = MFMA(pa[s], bv[s], accO);
#pragma unroll
      for (int s = 0; s < 16; ++s) { const bf16x8 br = *(const bf16x8*)(lds + (cc & 1) * 16384 + l31v * 512 + (((2 * s + hiv) ^ (l31v & 15)) << 4)); accQ = MFMA(bq[s], br, accQ); }
#pragma unroll
      for (int r = 0; r < 16; ++r) {
        const int i2 = 32 * w + crow(r, hiv); const float e = dir ? (float)(128 - i2) : (float)(i2 + 1);
        const float o = accO[r] + ex2(lg * e) * accQ[r];
        const int row = r0 + i2;
        *(bf16_t*)(obuf + (unsigned)(row * 2048 + hh * 512 + dvs * 32 + l31v) * 2u) = f2bf(o);
        float sq = o * o;
        sq = dpp_xadd<0xB1>(sq); sq = dpp_xadd<0x4E>(sq); sq = dpp_xadd<0x141>(sq); sq = dpp_xadd<0x140>(sq);
        sq += __shfl_xor(sq, 16);
        if (l31v == 0) ssq[(row * 4 + hh) * 16 + dvs] = sq;
      }
      __builtin_amdgcn_sched_barrier(0);
      bf16x8 ak[2][8];
      if (cc < 33) {
        const unsigned kto = (unsigned)((((hh * 8 + 2 * w) * 136 + (r0 >> 7)) * 8) * 64 + l31v + 32 * hiv) * 16u;
#pragma unroll
        for (int td = 0; td < 2; ++td)
#pragma unroll
          for (int s = 0; s < 8; ++s) ak[td][s] = *(const bf16x8*)(kT + (kto + (unsigned)(td * 136 * 8 * 64 * 16) + 1024u * s));
      }
      if (cc < 33) {
#pragma unroll
        for (int a = 0; a < 2; ++a)
#pragma unroll
          for (int r = 0; r < 16; ++r) accR[a][r] *= cdec;
#pragma unroll
        for (int s = 0; s < 8; ++s) {
          float z[8];
          { const int j0 = 16 * s + 8 * hiv; z[0] = ex2(lg * (float)(dir ? j0 : 127 - j0));
#pragma unroll
            for (int e = 1; e < 8; ++e) z[e] = z[e - 1] * gstep; }
          const u32x4 raw = __builtin_bit_cast(u32x4, bv[s]);
          u32x4 sc;
          sc.x = pk2(bflo(raw.x) * z[0], bfhi(raw.x) * z[1]); sc.y = pk2(bflo(raw.y) * z[2], bfhi(raw.y) * z[3]);
          sc.z = pk2(bflo(raw.z) * z[4], bfhi(raw.z) * z[5]); sc.w = pk2(bflo(raw.w) * z[6], bfhi(raw.w) * z[7]);
          const bf16x8 bvs = __builtin_bit_cast(bf16x8, sc);
          accR[0] = MFMA(ak[0][s], bvs, accR[0]); accR[1] = MFMA(ak[1][s], bvs, accR[1]);
        }
        const int r1 = ret_r0(cc + 1, dir, b);
        const unsigned po = (unsigned)((((((r1 >> 5) + w) * 4 + hh) * 16) * 64) + l31v + 32 * hiv) * 16u;
        const unsigned pf = (unsigned)((r1 + (dir * 4 + w) * 16 + hiv) * 1024 + hh * 256 + l31v * 8) * 2u;
        const unsigned vo = (unsigned)((((hh * 16 + dvs) * 136 + (r1 >> 7)) * 8) * 64 + l31v + 32 * hiv) * 16u;
#pragma unroll
        for (int s = 0; s < 8; ++s) { pa[s] = *(const bf16x8*)(pd + (pf + 4096u * s)); bv[s] = *(const bf16x8*)(vT + (vo + 1024u * s)); }
#pragma unroll
        for (int s = 0; s < 16; ++s) bq[s] = *(const bf16x8*)(q + (po + 1024u * s));
        __builtin_amdgcn_sched_barrier(0);
        write_rt(accR, lds + ((cc + 1) & 1) * 16384, w, l31v, hiv);
        __syncthreads();
      }
    }
  }
}

DI void att_phase(const Params& P, int l, char* lds, int wid_s) {
  const int tid = otid(), lane = tid & 63, w = tid >> 6, l31 = lane & 31, hi = lane >> 5, il = l >> 1;
  const bf16_t* q = (const bf16_t*)(P.ws + OFF_AR); const bf16_t* k = (const bf16_t*)(P.ws + OFF_AR + SZ_U);
  const bf16_t* vT = (const bf16_t*)(P.ws + OFF_AR + 2 * SZ_U); bf16_t* att = (bf16_t*)(P.ws + OFF_AR + 5 * SZ_U);
  const float csc = 0.125f * 1.4426950408889634f;
  for (int item = blockIdx.x; item < (l == 3 ? 1024 : 1024 + 64); item += gridDim.x) {
    int b, hh, R0, nt, nlat;
    if (item < 1024) { b = item >> 8; hh = (item >> 5) & 7; R0 = b * 4096 + 128 * (item & 31); nt = 68; nlat = 64; }
    else { const int i2 = item - 1024; b = i2 >> 4; hh = (i2 >> 1) & 7; R0 = TL + b * 256 + 128 * (i2 & 1); nt = 4; nlat = 0; }
    const int qrow = R0 + 32 * w + l31;
    bf16x8 bq[2][4];
#pragma unroll
    for (int r2 = 0; r2 < 2; ++r2)
#pragma unroll
      for (int s = 0; s < 4; ++s) bq[r2][s] = *(const bf16x8*)(q + (size_t)qrow * 1024 + hh * 128 + 64 * r2 + 16 * s + 8 * hi);
    f32x16 oT[2][4];
#pragma unroll
    for (int r2 = 0; r2 < 2; ++r2)
#pragma unroll
      for (int a = 0; a < 4; ++a)
#pragma unroll
        for (int r = 0; r < 16; ++r) oT[r2][a][r] = 0.f;
    float mrun[2] = {-1e30f, -1e30f}, lsum[2] = {0.f, 0.f};
    auto keybase = [&](int t) { return t < nlat ? b * 4096 + 64 * t : TL + b * 256 + 64 * (t - nlat); };
    auto dma = [&](int t, int buf) {
      int t2 = tid; asm volatile("" : "+v"(t2));
      const int kch = (t2 & 15) ^ ((t2 >> 4) & 15), krow_l = t2 >> 4;
      const int vch = (t2 & 7) ^ ((t2 >> 4) & 7), vrow_l = t2 >> 3;
      const int kb = keybase(t);
      const unsigned ko = (unsigned)((kb + krow_l) * 1024 + hh * 128 + kch * 8) * 2u;
      const unsigned vo = (unsigned)((hh * 128 + vrow_l) * T + kb + vch * 8) * 2u;
      char* kd = lds + buf * 16384 + t2 * 16; char* vd = lds + 32768 + buf * 16384 + t2 * 16;
#pragma unroll
      for (int i = 0; i < 4; ++i) {
        GLDS((const char*)k + (ko + (unsigned)(i * 16 * 1024 * 2)), kd + i * 4096);
        GLDS((const char*)vT + (vo + (unsigned)(i * 32 * T * 2)), vd + i * 4096);
      }
    };
    __syncthreads();
    dma(0, 0);
    asm volatile("s_waitcnt vmcnt(0)" ::: "memory");
    __syncthreads();
    for (int t = 0; t < nt; ++t) {
      const char* kb_ = lds + (t & 1) * 16384; const char* vb_ = lds + 32768 + (t & 1) * 16384;
      if (t + 1 < nt) dma(t + 1, (t + 1) & 1);
#pragma unroll
      for (int r2 = 0; r2 < 2; ++r2) {
        int l31v = l31, hiv = hi; asm volatile("" : "+v"(l31v), "+v"(hiv));
        f32x16 st[2];
#pragma unroll
        for (int jt = 0; jt < 2; ++jt) {
#pragma unroll
          for (int r = 0; r < 16; ++r) st[jt][r] = 0.f;
          const int row = 32 * jt + l31v;
#pragma unroll
          for (int s = 0; s < 4; ++s) { const bf16x8 ak = *(const bf16x8*)(kb_ + row * 256 + (((8 * r2 + 2 * s + hiv) ^ (row & 15)) << 4)); st[jt] = MFMA(ak, bq[r2][s], st[jt]); }
        }
        float mx = st[0][0];
#pragma unroll
        for (int r = 1; r < 16; ++r) mx = fmaxf(mx, st[0][r]);
#pragma unroll
        for (int r = 0; r < 16; ++r) mx = fmaxf(mx, st[1][r]);
        mx = fmaxf(mx, __shfl_xor(mx, 32));
        const float mnew = fmaxf(mrun[r2], mx * csc), alpha = ex2(mrun[r2] - mnew);
        mrun[r2] = mnew;
        float ps = 0.f;
#pragma unroll
        for (int jt = 0; jt < 2; ++jt)
#pragma unroll
          for (int r = 0; r < 16; ++r) { const float p = ex2(st[jt][r] * csc - mnew); st[jt][r] = p; ps += p; }
        lsum[r2] = lsum[r2] * alpha + ps;
#pragma unroll
        for (int a = 0; a < 4; ++a)
#pragma unroll
          for (int r = 0; r < 16; ++r) oT[r2][a][r] *= alpha;
#pragma unroll
        for (int jt = 0; jt < 2; ++jt)
#pragma unroll
          for (int s2 = 0; s2 < 2; ++s2) {
            const bf16x8 pb = pack8(st[jt], s2);
            const int chunk = 4 * jt + 2 * s2 + hiv;
#pragma unroll
            for (int tv = 0; tv < 4; ++tv) {
              const int v = 32 * tv + l31v, sw = (v >> 1) & 7;
              const bf16x8 av = *(const bf16x8*)(vb_ + v * 128 + ((chunk ^ sw) << 4));
              oT[r2][tv] = MFMA(av, pb, oT[r2][tv]);
              if (tv & 1) __builtin_amdgcn_sched_barrier(0);
            }
          }
      }
      asm volatile("s_waitcnt vmcnt(0)" ::: "memory");
      __syncthreads();
    }
    lsum[0] += __shfl_xor(lsum[0], 32); lsum[1] += __shfl_xor(lsum[1], 32);
    int lv = l; asm volatile("" : "+s"(lv));
    const float lam_init = (lv == 1) ? 0.3555090676f : 0.5560582042f;
    float d1 = 0.f, d2 = 0.f;
    for (int e = 0; e < 64; ++e) { d1 += P.lq1[il * 64 + e] * P.lk1[il * 64 + e]; d2 += P.lq2[il * 64 + e] * P.lk2[il * 64 + e]; }
    const float lam = ex2(d1 * 1.4426950408889634f) - ex2(d2 * 1.4426950408889634f) + lam_init;
    const float inv0 = __builtin_amdgcn_rcpf(lsum[0]), inv1 = lam * __builtin_amdgcn_rcpf(lsum[1]);
    float ss = 0.f;
#pragma unroll
    for (int a = 0; a < 4; ++a)
#pragma unroll
      for (int r = 0; r < 16; ++r) { const float o = oT[0][a][r] * inv0 - oT[1][a][r] * inv1; oT[0][a][r] = o; ss += o * o; }
    ss += __shfl_xor(ss, 32);
    const float rstd = __builtin_amdgcn_rsqf(ss * (1.f / 128.f) + EPS) * (1.f - lam_init);
    const float* sg = P.subln + il * 128;
    int t3 = tid; asm volatile("" : "+v"(t3));
    const int qrow2 = R0 + 32 * (t3 >> 6) + (t3 & 31), hi3 = (t3 >> 5) & 1;
#pragma unroll
    for (int a = 0; a < 4; ++a)
#pragma unroll
      for (int g = 0; g < 4; ++g) {
        const int v = 32 * a + 8 * g + 4 * hi3;
        const f32x4 gg = *(const f32x4*)(sg + v);
        u32x2 pk; pk.x = pk2(oT[0][a][4 * g] * rstd * gg.x, oT[0][a][4 * g + 1] * rstd * gg.y); pk.y = pk2(oT[0][a][4 * g + 2] * rstd * gg.z, oT[0][a][4 * g + 3] * rstd * gg.w);
        *(u32x2*)(att + (size_t)qrow2 * 1024 + hh * 128 + v) = pk;
      }
  }
}

__global__ void __launch_bounds__(NTH, 2) fwd_kernel(Params P) {
  __shared__ __attribute__((aligned(16))) char lds[65536];
  cg::grid_group grid = cg::this_grid();
  int ph = 0;
  __shared__ unsigned xb_st[4];
  const int wid_s = __builtin_amdgcn_readfirstlane((int)threadIdx.x >> 6);
  if (wid_s == 0 && lane_id() < 4) xb_st[lane_id()] = 0u;
  __syncthreads();
  const XcdBarrier xb = xcd_barrier_post((unsigned*)(P.ws + OFF_BAR), (volatile LAS unsigned*)xb_st, wid_s);
  const bf16_t* ymix = (const bf16_t*)(P.ws + OFF_AR + 3 * SZ_U); const bf16_t* yffn = (const bf16_t*)(P.ws + OFF_AR);
#define PHASE_BEGIN if (ph >= P.lo && ph < P.hi) {
#define PHASE_END if (ph + 1 < P.hi) { if (P.lo < 0) grid.sync(); xcd_barrier(xb, wid_s); } } ++ph;
#ifndef PH_MASK
#define PH_MASK 0xffff
#endif
#define HAS(n) ((PH_MASK >> (n)) & 1)
#ifndef REP
#define REP 0
#endif
#define NREP(n) (((REP >> (n)) & 1) ? 2 : 1)
  PHASE_BEGIN
#if HAS(0)
    for (int rr = 0; rr < NREP(0); ++rr) mod_phase(P, lds, wid_s);
#endif
#if HAS(1)
    for (int rr = 0; rr < NREP(1); ++rr) { int base = 384; conv_mixer(P, 0, lds, base, wid_s); conv_ffn(P, 0, lds, base, wid_s); }
#endif
  PHASE_END
  for (int l = 0; l < 4; ++l) {
    const bool ret = (l & 1) == 0;
    PHASE_BEGIN
#if HAS(2)
      if (l == 0) pn_phase(P, -1, 0, 0, 0, true, nullptr, wid_s); else pn_phase(P, l - 1, 1, l, 0, false, yffn, wid_s);
#endif
#if HAS(1)
      if (l > 0) for (int rr = 0; rr < NREP(1); ++rr) { int base = 0; conv_ffn(P, l, lds, base, wid_s); }
#endif
    PHASE_END
    PHASE_BEGIN
#if HAS(3)
      for (int rr = 0; rr < NREP(3); ++rr) gemm_phase(P, ret ? GP_RET_IN : GP_DIFF_IN, lds, l, wid_s);
#endif
    PHASE_END
    if (ret) { PHASE_BEGIN
#if HAS(3)
      gemm_phase(P, GP_RET_S, lds, l, wid_s);
#endif
    PHASE_END }
    PHASE_BEGIN
#if HAS(4)
      if (ret) for (int rr = 0; rr < NREP(4); ++rr) ret_phase(P, l, lds, wid_s);
#endif
#if HAS(5)
      if (!ret) for (int rr = 0; rr < NREP(5); ++rr) att_phase(P, l, lds, wid_s);
#endif
    PHASE_END
    if (ret) { PHASE_BEGIN
#if HAS(3)
      for (int rr = 0; rr < NREP(3); ++rr) gemm_phase(P, GP_RET_GATE, lds, l, wid_s);
#endif
    PHASE_END }
    PHASE_BEGIN
#if HAS(3)
      for (int rr = 0; rr < NREP(3); ++rr) gemm_phase(P, ret ? GP_RET_OUT : GP_DIFF_OUT, lds, l, wid_s);
#endif
    PHASE_END
    PHASE_BEGIN
#if HAS(2)
      pn_phase(P, l, 0, l, 1, l == 0, ymix, wid_s);
#endif
#if HAS(1)
      if (l < 3) for (int rr = 0; rr < NREP(1); ++rr) { int base = 0; conv_mixer(P, l + 1, lds, base, wid_s); }
#endif
    PHASE_END
    PHASE_BEGIN
#if HAS(3)
      for (int rr = 0; rr < NREP(3); ++rr) gemm_phase(P, GP_FFN_UP, lds, l, wid_s);
#endif
    PHASE_END
    PHASE_BEGIN
#if HAS(6)
      for (int rr = 0; rr < NREP(6); ++rr) act_phase(P, l, wid_s);
#endif
    PHASE_END
    PHASE_BEGIN
#if HAS(3)
      for (int rr = 0; rr < NREP(3); ++rr) gemm_phase(P, GP_FFN_DOWN, lds, l, wid_s);
#endif
    PHASE_END
  }
  PHASE_BEGIN
#if HAS(2)
    pn_phase(P, 3, 1, -1, 0, false, yffn, wid_s);
#endif
  PHASE_END
}
constexpr int N_PHASES = 1 + 10 + 8 + 10 + 8 + 1;
#ifdef STOP_AT
__global__ void dump_kernel(const unsigned short* ws, float* out, size_t nws16) {
  size_t i = (size_t)blockIdx.x * 256 + threadIdx.x;
  unsigned acc = 0;
  for (size_t j = i; j < nws16; j += (size_t)TL * 1024) acc = acc * 31u + ws[j];
  out[i] = (float)(acc & 0xFFFFu) * (1.f / 65536.f);
}
#endif

extern "C" void kernel_launch(void* const* d_in, const int* in_sizes, int n_in, void* d_out, int out_size, void* d_ws, size_t ws_size, hipStream_t stream) {
  static int grid_blocks = 0;
  if (!grid_blocks) {
    int dev = 0, cus = 0, per_cu = 0;
    hipGetDevice(&dev);
    hipDeviceGetAttribute(&cus, hipDeviceAttributeMultiprocessorCount, dev);
    hipOccupancyMaxActiveBlocksPerMultiprocessor(&per_cu, fwd_kernel, NTH, 0);
    if (per_cu > 2) per_cu = 2;
    if (per_cu < 1) per_cu = 1;
    grid_blocks = cus * per_cu;
  }
  if (ws_size < WS_NEED) fprintf(stderr, "workspace too small: %zu < %zu\n", ws_size, (size_t)WS_NEED);
  Params p{};
  const float** f = (const float**)&p;
  for (int i = 0; i < 22; ++i) f[i] = (const float*)d_in[i];
  p.out = (float*)d_out; p.ws = (char*)d_ws;
#if MULTI_LAUNCH
#ifdef STOP_AT
  for (int ph = 0; ph < STOP_AT; ++ph) { p.lo = ph; p.hi = ph + 1; hipLaunchKernelGGL(fwd_kernel, dim3(grid_blocks), dim3(NTH), 0, stream, p); }
  hipLaunchKernelGGL(dump_kernel, dim3(TL * 1024 / 256), dim3(256), 0, stream, (const unsigned short*)d_ws, (float*)d_out, (size_t)WS_NEED / 2);
#else
  for (int ph = 0; ph < N_PHASES; ++ph) { p.lo = ph; p.hi = ph + 1; hipLaunchKernelGGL(fwd_kernel, dim3(grid_blocks), dim3(NTH), 0, stream, p); }
#endif
#else
  p.lo = 0; p.hi = N_PHASES;
  hipMemsetAsync((char*)d_ws + OFF_BAR, 0, 16384, stream);
  void* args[] = {&p};
  hipError_t e = hipLaunchCooperativeKernel((void*)fwd_kernel, dim3(grid_blocks), dim3(NTH), args, 0, stream);
  if (e != hipSuccess) fprintf(stderr, "cooperative launch failed: %s (grid %d)\n", hipGetErrorString(e), grid_blocks);
#endif
}
```

```cpp
#include <hip/hip_runtime.h>
#include <hip/hip_cooperative_groups.h>
#include <cstdio>
#include <cstdint>
namespace cg = cooperative_groups;

#ifndef MULTI_LAUNCH
#define MULTI_LAUNCH 0
#endif

typedef unsigned short bf16_t;
typedef short bf16x8 __attribute__((ext_vector_type(8)));
typedef short s16x4 __attribute__((ext_vector_type(4)));
typedef float f32x16 __attribute__((ext_vector_type(16)));
typedef float f32x4 __attribute__((ext_vector_type(4)));
typedef float f32x2 __attribute__((ext_vector_type(2)));
typedef unsigned u32x4 __attribute__((ext_vector_type(4)));
typedef unsigned u32x2 __attribute__((ext_vector_type(2)));
typedef __bf16 bf2_t __attribute__((ext_vector_type(2)));

#define DI __device__ __forceinline__
typedef __attribute__((address_space(3))) unsigned lds_u32_t;
#define GLDS(gp, lp) __builtin_amdgcn_global_load_lds((const unsigned*)(gp), (lds_u32_t*)(lp), 16, 0, 0)
#define MFMA(a, b, c) __builtin_amdgcn_mfma_f32_32x32x16_bf16((a), (b), (c), 0, 0, 0)

constexpr int T = 17408, TL = 16384, DM = 1024, NTH = 256;
constexpr float EPS = 1e-6f;
constexpr size_t SZ_U = (size_t)T * 1024 * 2;
constexpr size_t OFF_MOD = 0;
constexpr size_t OFF_TABR = OFF_MOD + 4 * 5 * 6144 * 4;
constexpr size_t OFF_TABD = OFF_TABR + 64 * 64 * 8;
constexpr size_t OFF_SSQ = OFF_TABD + 64 * 16 * 8;
constexpr size_t OFF_HC = OFF_SSQ + (size_t)T * 64 * 4 * 2;
constexpr size_t OFF_U = OFF_HC + 1024 * 1024 * 4;
constexpr size_t OFF_WM = OFF_U + SZ_U;
constexpr size_t OFF_WF = OFF_WM + (size_t)8192 * 1024 * 2 + (size_t)1024 * 2048 * 2;
constexpr size_t OFF_AR = OFF_WF + (size_t)5632 * 1024 * 2 + (size_t)1024 * 2816 * 2;
constexpr size_t OFF_BAR = OFF_AR + 9 * SZ_U;
constexpr size_t WS_NEED = OFF_BAR + 16384;

struct Params {
  const float *x, *c, *ctx, *c_ctx, *ada_w, *ada_b, *norm_g, *ret_w_in, *ret_w_out, *ret_df, *ret_db;
  const float *diff_w_in, *diff_w_out, *lq1, *lk1, *lq2, *lk2, *subln, *ffn_up, *ffn_cw, *ffn_cb, *ffn_down;
  float* out; char* ws; int lo, hi;
};

DI unsigned pk2(float lo, float hi) { f32x2 v = {lo, hi}; bf2_t b = __builtin_convertvector(v, bf2_t); return __builtin_bit_cast(unsigned, b); }
DI bf16_t f2bf(float x) { return (bf16_t)(pk2(x, 0.f) & 0xffffu); }
DI float bflo(unsigned u) { return __uint_as_float(u << 16); }
DI float bfhi(unsigned u) { return __uint_as_float(u & 0xffff0000u); }
DI float bf2f(bf16_t x) { return __uint_as_float((unsigned)x << 16); }
DI int crow(int reg, int h) { return (reg & 3) + 8 * (reg >> 2) + 4 * h; }
DI float ex2(float x) { return __builtin_amdgcn_exp2f(x); }
DI float wsum(float v) { for (int m = 32; m >= 1; m >>= 1) v += __shfl_xor(v, m); return v; }
DI float siluf(float x) { return x * __builtin_amdgcn_rcpf(1.f + __expf(-x)); }
DI bf16x8 pack8(const f32x16& x, int s) {
  u32x4 p; p.x = pk2(x[8 * s], x[8 * s + 1]); p.y = pk2(x[8 * s + 2], x[8 * s + 3]); p.z = pk2(x[8 * s + 4], x[8 * s + 5]); p.w = pk2(x[8 * s + 6], x[8 * s + 7]);
  return __builtin_bit_cast(bf16x8, p);
}
DI int lane_id() { return (int)__builtin_amdgcn_mbcnt_hi(~0u, __builtin_amdgcn_mbcnt_lo(~0u, 0u)); }
DI int otid_w(int wid_s) { int t = (wid_s << 6) | lane_id(); asm volatile("" : "+v"(t)); return t; }
#define otid() otid_w(wid_s)
DI f32x2 rope_cs(int pos, int fi, float cexp) {
  const float ang = (float)pos * ex2(-(float)fi * cexp);
  const float rev = ang * 0.15915494309189535f;
  const float fr = rev - rintf(rev);
  f32x2 cs; cs.x = __builtin_amdgcn_cosf(fr); cs.y = __builtin_amdgcn_sinf(fr); return cs;
}
#define XB_TMO      128
#define XB_XCNT(j)  (256  + 64 * (j))
#define XB_XSUB(j)  (1280 + 64 * (j))
#define XB_XGEN(j)  (2304 + 64 * (j))
#define XB_TOP      3328
#define XB_TOPGEN   3392
#define XB_SPIN_CAP (1u << 22)
#define LAS __attribute__((address_space(3)))
DI unsigned xb_ld(unsigned* p) { return __hip_atomic_load(p, __ATOMIC_RELAXED, __HIP_MEMORY_SCOPE_AGENT); }
DI unsigned xb_add(unsigned* p, unsigned v) { return __hip_atomic_fetch_add(p, v, __ATOMIC_RELAXED, __HIP_MEMORY_SCOPE_AGENT); }
DI unsigned xb_xcc_id() { return (unsigned)__builtin_amdgcn_s_getreg((3 << 11) | 20) & 0xFu; }
#define XB_SPIN(cond, bar) do { unsigned _sp = 0; while (cond) { __builtin_amdgcn_s_sleep(1); \
    if ((++_sp & 255u) == 0u) { if (xb_ld(&(bar)[XB_TMO])) break; if (_sp > XB_SPIN_CAP) { atomicAdd(&(bar)[XB_TMO], 1u); break; } } } } while (0)
struct XcdBarrier { unsigned* bar; unsigned x; volatile LAS unsigned* st; };
DI XcdBarrier xcd_barrier_post(unsigned* bar, volatile LAS unsigned* st, int wid_s) {
  XcdBarrier b; b.bar = bar; b.x = xb_xcc_id(); b.st = st;
  if (wid_s == 0 && lane_id() == 0) (void)xb_add(&bar[XB_XCNT(b.x)], 1u);
  return b;
}
DI void xcd_barrier_complete(unsigned* bar, unsigned x, unsigned& nloc, unsigned& nx) {
  const unsigned G = gridDim.x;
  unsigned sum, cnt, mine, sp = 0u;
  for (;;) {
    sum = 0u; cnt = 0u; mine = 0u;
#pragma unroll
    for (unsigned j = 0; j < 16; ++j) { const unsigned c = xb_ld(&bar[XB_XCNT(j)]); sum += c; cnt += (c > 0u) ? 1u : 0u; mine = (j == x) ? c : mine; }
    if (sum == G) break;
    __builtin_amdgcn_s_sleep(1);
    if ((++sp & 255u) == 0u) { if (xb_ld(&bar[XB_TMO])) break; if (sp > XB_SPIN_CAP) { atomicAdd(&bar[XB_TMO], 1u); break; } }
  }
  nloc = mine > 0u ? mine : 1u; nx = cnt > 0u ? cnt : 1u;
}
DI void xcd_barrier(const XcdBarrier& b, int wid_s) {
  asm volatile("s_waitcnt vmcnt(0)" ::: "memory");
  __syncthreads();
  if (wid_s == 0 && lane_id() == 0) {
    unsigned* bar = b.bar;
    __builtin_amdgcn_s_waitcnt(0);
    unsigned nloc = b.st[0], nx = b.st[1];
    if (nloc == 0u) { xcd_barrier_complete(bar, b.x, nloc, nx); b.st[0] = nloc; b.st[1] = nx; }
    const unsigned old = xb_add(&bar[XB_XSUB(b.x)], 1u);
    const unsigned gen = old / nloc;
    if (old + 1u == (gen + 1u) * nloc) {
      __builtin_amdgcn_fence(__ATOMIC_RELEASE, "agent");
      asm volatile("s_waitcnt vmcnt(0)" ::: "memory");
      const unsigned og = xb_add(&bar[XB_TOP], 1u);
      const unsigned tg = og / nx;
      if (og + 1u == (tg + 1u) * nx) xb_add(&bar[XB_TOPGEN], 1u);
      else XB_SPIN(xb_ld(&bar[XB_TOPGEN]) == tg, bar);
      __builtin_amdgcn_fence(__ATOMIC_ACQUIRE, "agent");
      xb_add(&bar[XB_XGEN(b.x)], 1u);
      asm volatile("s_waitcnt vmcnt(0)" ::: "memory");
    } else {
      XB_SPIN(xb_ld(&bar[XB_XGEN(b.x)]) == gen, bar);
      __builtin_amdgcn_fence(__ATOMIC_ACQUIRE, "agent");
      asm volatile("s_waitcnt vmcnt(0)" ::: "memory");
    }
  }
  __syncthreads();
}
template <int CTRL> DI float dpp_xadd(float x) { return x + __int_as_float(__builtin_amdgcn_update_dpp(0, __float_as_int(x), CTRL, 0xF, 0xF, true)); }
DI int rowbsel(int row) { return row < TL ? (row >> 12) : 4; }

DI int srccol(int g, int mode) {
  if (mode == 1) {
    if (g < 2048) return (g & ~127) + 32 * ((g >> 6) & 1) + (g & 31) + 64 * ((g >> 5) & 1);
    if (g < 4096) return g;
    int gp = g - 4096; return 4096 + 2048 * ((gp >> 5) & 1) + 32 * (gp >> 6) + (gp & 31);
  }
  if (mode == 2) {
    if (g < 2048) { int c = g & 31; return (g & ~63) + (c < 16 ? c : c + 16) + 16 * ((g >> 5) & 1); }
    return g;
  }
  if (mode == 3) return 64 * (g >> 7) + (g & 63) + 2816 * ((g >> 6) & 1);
  return g;
}
DI void conv_range(const float* __restrict__ src, int nsrc, bf16_t* __restrict__ dst, int K, int nrows, int mode, char* lds, int& base, int wid_s) {
  float (*tile)[65] = (float (*)[65])lds;
  const int tid = otid(), nkb = K >> 6, nitems = (nrows >> 6) * nkb, G = gridDim.x;
  int it = (int)((blockIdx.x + G - (base % G)) % G);
  float r[16];
  if (it < nitems) {
    const int g0 = (it / nkb) * 64, k0 = (it % nkb) * 64;
#pragma unroll
    for (int i = 0; i < 16; ++i) { int e = tid + 256 * i, kk = e >> 6, gg = e & 63; r[i] = src[(size_t)(k0 + kk) * nsrc + srccol(g0 + gg, mode)]; }
  }
  for (; it < nitems; it += G) {
    const int g0 = (it / nkb) * 64, k0 = (it % nkb) * 64;
#pragma unroll
    for (int i = 0; i < 16; ++i) { int e = tid + 256 * i, kk = e >> 6, gg = e & 63; tile[kk][gg] = r[i]; }
    __syncthreads();
    if (it + G < nitems) {
      const int g1 = ((it + G) / nkb) * 64, k1 = ((it + G) % nkb) * 64;
#pragma unroll
      for (int i = 0; i < 16; ++i) { int e = tid + 256 * i, kk = e >> 6, gg = e & 63; r[i] = src[(size_t)(k1 + kk) * nsrc + srccol(g1 + gg, mode)]; }
    }
    const int gg = tid >> 2, kq = (tid & 3) * 16;
    u32x4 w0, w1;
    w0.x = pk2(tile[kq + 0][gg], tile[kq + 1][gg]); w0.y = pk2(tile[kq + 2][gg], tile[kq + 3][gg]); w0.z = pk2(tile[kq + 4][gg], tile[kq + 5][gg]); w0.w = pk2(tile[kq + 6][gg], tile[kq + 7][gg]);
    w1.x = pk2(tile[kq + 8][gg], tile[kq + 9][gg]); w1.y = pk2(tile[kq + 10][gg], tile[kq + 11][gg]); w1.z = pk2(tile[kq + 12][gg], tile[kq + 13][gg]); w1.w = pk2(tile[kq + 14][gg], tile[kq + 15][gg]);
    bf16_t* d = dst + (size_t)(g0 + gg) * K + k0 + kq;
    *(u32x4*)d = w0; *(u32x4*)(d + 8) = w1;
    __syncthreads();
  }
  base += nitems;
}
DI void conv_mixer(const Params& P, int l, char* lds, int& base, int wid_s) {
  bf16_t* WM = (bf16_t*)(P.ws + OFF_WM); const int i = l >> 1;
  if ((l & 1) == 0) {
    conv_range(P.ret_w_in + (size_t)i * 1024 * 8192, 8192, WM, 1024, 8192, 1, lds, base, wid_s);
    conv_range(P.ret_w_out + (size_t)i * 2048 * 1024, 1024, WM + (size_t)8192 * 1024, 2048, 1024, 0, lds, base, wid_s);
  } else {
    conv_range(P.diff_w_in + (size_t)i * 1024 * 3072, 3072, WM, 1024, 3072, 2, lds, base, wid_s);
    conv_range(P.diff_w_out + (size_t)i * 1024 * 1024, 1024, WM + (size_t)3072 * 1024, 1024, 1024, 0, lds, base, wid_s);
  }
}
DI void conv_ffn(const Params& P, int l, char* lds, int& base, int wid_s) {
  bf16_t* WF = (bf16_t*)(P.ws + OFF_WF);
  conv_range(P.ffn_up + (size_t)l * 1024 * 5632, 5632, WF, 1024, 5632, 3, lds, base, wid_s);
  conv_range(P.ffn_down + (size_t)l * 2816 * 1024, 1024, WF + (size_t)5632 * 1024, 2816, 1024, 0, lds, base, wid_s);
}

DI void mod_phase(const Params& P, char* lds, int wid_s) {
  const int tid = otid();
  float* sc = (float*)lds; float* red = (float*)(lds + 20480);
  float* mod = (float*)(P.ws + OFF_MOD);
  for (int e = tid; e < 5120; e += NTH) { int bs = e >> 10, k = e & 1023; float v = bs < 4 ? P.c[bs * 1024 + k] : P.c_ctx[k]; sc[e] = v / (1.f + __expf(-v)); }
  __syncthreads();
  for (int item = blockIdx.x; item < 384; item += gridDim.x) {
    const int l = item / 96, cgp = item % 96, kq = tid >> 6, cl = tid & 63, col = cgp * 64 + cl;
    float a0 = 0, a1 = 0, a2 = 0, a3 = 0, a4 = 0;
    const float* w = P.ada_w + ((size_t)l * 1024 + kq * 256) * 6144 + col;
#pragma unroll 8
    for (int k = 0; k < 256; ++k) { float wv = w[(size_t)k * 6144]; int kk = kq * 256 + k; a0 += sc[kk] * wv; a1 += sc[1024 + kk] * wv; a2 += sc[2048 + kk] * wv; a3 += sc[3072 + kk] * wv; a4 += sc[4096 + kk] * wv; }
    red[(kq * 5 + 0) * 64 + cl] = a0; red[(kq * 5 + 1) * 64 + cl] = a1; red[(kq * 5 + 2) * 64 + cl] = a2; red[(kq * 5 + 3) * 64 + cl] = a3; red[(kq * 5 + 4) * 64 + cl] = a4;
    __syncthreads();
    for (int e = tid; e < 320; e += NTH) { int bs = e >> 6, c2 = e & 63; float s = red[(0 * 5 + bs) * 64 + c2] + red[(1 * 5 + bs) * 64 + c2] + red[(2 * 5 + bs) * 64 + c2] + red[(3 * 5 + bs) * 64 + c2];
      mod[(size_t)(l * 5 + bs) * 6144 + cgp * 64 + c2] = s + P.ada_b[l * 6144 + cgp * 64 + c2]; }
    __syncthreads();
  }
}

DI void pn_phase(const Params& P, int l_res, int which_res, int l_pre, int which_pre, bool h_from_input, const bf16_t* ybuf, int wid_s) {
  const int tid0 = otid(); const int lane = tid0 & 63, w = tid0 >> 6;
  const float* mod = (const float*)(P.ws + OFF_MOD);
  float* hc = (float*)(P.ws + OFF_HC); bf16_t* u = (bf16_t*)(P.ws + OFF_U);
  const int nrows = (l_pre < 0 || (l_res == 3 && which_res == 0)) ? TL : T;
  const int nw = gridDim.x * 4;
  for (int row0 = blockIdx.x * 4 + w; row0 < nrows; row0 += 2 * nw) {
    int rows[2] = {row0, row0 + nw};
    const bool has1 = rows[1] < nrows; if (!has1) rows[1] = row0;
    const float* hin[2]; float* hout[2]; int bs[2];
    f32x4 hv[2][4], yv[2][4];
#pragma unroll
    for (int k = 0; k < 2; ++k) {
      const int row = rows[k]; bs[k] = rowbsel(row);
      hin[k] = h_from_input ? (row < TL ? P.x + (size_t)row * 1024 : P.ctx + (size_t)(row - TL) * 1024)
                            : (row < TL ? P.out + (size_t)row * 1024 : hc + (size_t)(row - TL) * 1024);
      hout[k] = row < TL ? P.out + (size_t)row * 1024 : hc + (size_t)(row - TL) * 1024;
#pragma unroll
      for (int i = 0; i < 4; ++i) hv[k][i] = *(const f32x4*)(hin[k] + lane * 4 + 256 * i);
      if (l_res >= 0) {
#pragma unroll
        for (int i = 0; i < 4; ++i) {
          if (row < TL) { const u32x2 yr = *(const u32x2*)(ybuf + (size_t)row * 1024 + lane * 4 + 256 * i); yv[k][i] = (f32x4){bflo(yr.x), bfhi(yr.x), bflo(yr.y), bfhi(yr.y)}; }
          else {
            const float* yp = (const float*)(P.ws + OFF_AR + 4 * SZ_U) + (size_t)(row - TL) * 1024 + lane * 4 + 256 * i;
            yv[k][i] = (*(const f32x4*)yp + *(const f32x4*)(yp + 1024 * 1024)) + (*(const f32x4*)(yp + 2 * 1024 * 1024) + *(const f32x4*)(yp + 3 * 1024 * 1024));
          }
        }
      }
    }
#pragma unroll
    for (int k = 0; k < 2; ++k) {
      if (k == 1 && !has1) break;
      const int row = rows[k];
      if (l_res >= 0) {
        float ss = 0.f;
#pragma unroll
        for (int i = 0; i < 4; ++i) ss += yv[k][i].x * yv[k][i].x + yv[k][i].y * yv[k][i].y + yv[k][i].z * yv[k][i].z + yv[k][i].w * yv[k][i].w;
        ss = wsum(ss); const float rstd = rsqrtf(ss * (1.f / 1024.f) + EPS);
        const float* gate = mod + (size_t)(l_res * 5 + bs[k]) * 6144 + (which_res ? 5 : 2) * 1024;
        const float* gp = P.norm_g + (size_t)(l_res * 4 + (which_res ? 3 : 1)) * 1024;
#pragma unroll
        for (int i = 0; i < 4; ++i) { f32x4 gt = *(const f32x4*)(gate + lane * 4 + 256 * i), gg = *(const f32x4*)(gp + lane * 4 + 256 * i); hv[k][i] += gt * (yv[k][i] * rstd * gg); *(f32x4*)(hout[k] + lane * 4 + 256 * i) = hv[k][i]; }
      }
      if (l_pre >= 0) {
        float ss = 0.f;
#pragma unroll
        for (int i = 0; i < 4; ++i) ss += hv[k][i].x * hv[k][i].x + hv[k][i].y * hv[k][i].y + hv[k][i].z * hv[k][i].z + hv[k][i].w * hv[k][i].w;
        ss = wsum(ss); const float rstd = rsqrtf(ss * (1.f / 1024.f) + EPS);
        const float* g = P.norm_g + (size_t)(l_pre * 4 + (which_pre ? 2 : 0)) * 1024;
        const float* sh = mod + (size_t)(l_pre * 5 + bs[k]) * 6144 + (which_pre ? 3 : 0) * 1024;
        const float* scv = mod + (size_t)(l_pre * 5 + bs[k]) * 6144 + (which_pre ? 4 : 1) * 1024;
#pragma unroll
        for (int i = 0; i < 4; ++i) {
          f32x4 gg = *(const f32x4*)(g + lane * 4 + 256 * i), s1 = *(const f32x4*)(sh + lane * 4 + 256 * i), s2 = *(const f32x4*)(scv + lane * 4 + 256 * i);
          f32x4 o = (hv[k][i] * rstd * gg) * (s2 + 1.f) + s1;
          u32x2 pk; pk.x = pk2(o.x, o.y); pk.y = pk2(o.z, o.w);
          *(u32x2*)(u + (size_t)row * 1024 + lane * 4 + 256 * i) = pk;
        }
      }
    }
  }
}

DI void act_phase(const Params& P, int l, int wid_s) {
  const bf16_t* __restrict__ vg = (const bf16_t*)(P.ws + OFF_AR); bf16_t* __restrict__ a = (bf16_t*)(P.ws + OFF_AR + 6 * SZ_U);
  const float* cw = P.ffn_cw + (size_t)l * 3 * 2816; const float* cb = P.ffn_cb + (size_t)l * 2816;
  const int tid = otid();
  for (int item = blockIdx.x; item < 272 * 352 / 256; item += gridDim.x) {
    const int u = item * 256 + tid; const int br = u / 352, ch = u - br * 352;
    const int r = (br >> 1) * 128 + (br & 1) * 127;
    const int p = r < TL ? (r & 4095) : ((r - TL) & 255); const int slen = r < TL ? 4096 : 256;
    const int f0 = ch * 8;
    const bf16_t* gp = vg + (size_t)r * 5632 + 2816 + f0;
    u32x4 g0 = {0, 0, 0, 0}, g2 = {0, 0, 0, 0};
    if (p != 0) g0 = *(const u32x4*)(gp - 5632);
    if (p + 1 < slen) g2 = *(const u32x4*)(gp + 5632);
    const u32x4 g1 = *(const u32x4*)gp, vv = *(const u32x4*)(vg + (size_t)r * 5632 + f0);
    float o[8];
#pragma unroll
    for (int qd = 0; qd < 4; ++qd) {
      const float x0 = cw[f0 + 2 * qd] * bflo(g0[qd]) + cw[2816 + f0 + 2 * qd] * bflo(g1[qd]) + cw[5632 + f0 + 2 * qd] * bflo(g2[qd]) + cb[f0 + 2 * qd];
      const float x1 = cw[f0 + 2 * qd + 1] * bfhi(g0[qd]) + cw[2816 + f0 + 2 * qd + 1] * bfhi(g1[qd]) + cw[5632 + f0 + 2 * qd + 1] * bfhi(g2[qd]) + cb[f0 + 2 * qd + 1];
      o[2 * qd] = siluf(x0) * bflo(vv[qd]); o[2 * qd + 1] = siluf(x1) * bfhi(vv[qd]);
    }
    u32x4 ov; ov.x = pk2(o[0], o[1]); ov.y = pk2(o[2], o[3]); ov.z = pk2(o[4], o[5]); ov.w = pk2(o[6], o[7]);
    *(u32x4*)(a + (size_t)r * 2816 + f0) = ov;
  }
}

enum { EPI_F32 = 0, EPI_BF16 = 1, EPI_ROPE_RET_N = 2, EPI_ROPE_RET_T = 3, EPI_ROPE_DIFF_N = 4, EPI_MERGE = 5, EPI_SMASK = 6, EPI_ACT = 7 };
struct Job { const bf16_t* A; const bf16_t* B; int lda, ldb, K, m0, n0, epi, ldc, aux, afrag; void* out; float scale; };

DI void gemm_tile(const Params& P, const Job& J, char* lds, int tid) {
  const int lane = tid & 63, w = tid >> 6, wm = w >> 1, wn = w & 1, l31 = lane & 31, hi = lane >> 5;
  f32x16 acc[2][2];
#pragma unroll
  for (int a = 0; a < 2; ++a)
#pragma unroll
    for (int b = 0; b < 2; ++b)
#pragma unroll
      for (int r = 0; r < 16; ++r) acc[a][b][r] = 0.f;
  const int lrow = tid >> 3, lkc = (tid & 7) ^ ((tid >> 4) & 7);
  const bf16_t* ga = J.afrag ? J.A + ((((size_t)(J.m0 >> 5) * 4 + (J.afrag - 1)) * 16 + (lkc >> 1)) * 64 + (lkc & 1) * 32 + lrow) * 8
                             : J.A + (size_t)(J.m0 + lrow) * J.lda + lkc * 8;
  const bf16_t* gb = J.B + (size_t)(J.n0 + lrow) * J.ldb + lkc * 8;
  const size_t sa = J.afrag ? (size_t)32768 : (size_t)32 * J.lda, sb = (size_t)32 * J.ldb;
  const size_t ksa = J.afrag ? 2048 : 64;
  const int swz = (lane >> 1) & 7;
  const int aoff = (64 * wm + l31) * 128, boff = 16384 + (64 * wn + l31) * 128;
  const int nk = J.K >> 6;
  char* wbase = lds + tid * 16;
#pragma unroll
  for (int i = 0; i < 4; ++i) { GLDS(ga + i * sa, wbase + i * 4096); GLDS(gb + i * sb, wbase + 16384 + i * 4096); }
  asm volatile("s_waitcnt vmcnt(0)" ::: "memory");
  __syncthreads();
  for (int kt = 0; kt < nk; ++kt) {
    const char* cur = lds + (kt & 1) * 32768; char* nxt = wbase + ((kt + 1) & 1) * 32768;
    if (kt + 1 < nk) {
#pragma unroll
      for (int i = 0; i < 4; ++i) { GLDS(ga + (size_t)(kt + 1) * ksa + i * sa, nxt + i * 4096); GLDS(gb + (size_t)(kt + 1) * 64 + i * sb, nxt + 16384 + i * 4096); }
    }
    bf16x8 fa[2][2], fb[2][2];
    { const int ko = ((0 + hi) ^ swz) << 4;
      fa[0][0] = *(const bf16x8*)(cur + aoff + ko); fa[0][1] = *(const bf16x8*)(cur + aoff + 4096 + ko);
      fb[0][0] = *(const bf16x8*)(cur + boff + ko); fb[0][1] = *(const bf16x8*)(cur + boff + 4096 + ko); }
#pragma unroll
    for (int s = 0; s < 4; ++s) {
      const int c = s & 1, n = c ^ 1;
      if (s < 3) {
        const int ko = ((2 * (s + 1) + hi) ^ swz) << 4;
        fa[n][0] = *(const bf16x8*)(cur + aoff + ko); fa[n][1] = *(const bf16x8*)(cur + aoff + 4096 + ko);
        fb[n][0] = *(const bf16x8*)(cur + boff + ko); fb[n][1] = *(const bf16x8*)(cur + boff + 4096 + ko);
      }
      acc[0][0] = MFMA(fa[c][0], fb[c][0], acc[0][0]); acc[0][1] = MFMA(fa[c][0], fb[c][1], acc[0][1]);
      acc[1][0] = MFMA(fa[c][1], fb[c][0], acc[1][0]); acc[1][1] = MFMA(fa[c][1], fb[c][1], acc[1][1]);
      __builtin_amdgcn_sched_barrier(0);
    }
    asm volatile("s_waitcnt vmcnt(0)" ::: "memory");
    __syncthreads();
  }
  int l31e = l31, hie = hi; asm volatile("" : "+v"(l31e), "+v"(hie));
  const int m0w = J.m0 + 64 * wm, n0w = J.n0 + 64 * wn;
  if (J.epi == EPI_F32) {
    float* o = (float*)J.out;
#pragma unroll
    for (int tm = 0; tm < 2; ++tm)
#pragma unroll
      for (int tn = 0; tn < 2; ++tn)
#pragma unroll
        for (int r = 0; r < 16; ++r) o[(size_t)(m0w + 32 * tm + crow(r, hie)) * J.ldc + n0w + 32 * tn + l31e] = acc[tm][tn][r];
    return;
  }
  constexpr int IST = 272;
  char* img = lds;
  bf16_t* obase; size_t oldc; int ocols = 128, ist = IST;
  if (J.epi == EPI_BF16) {
#pragma unroll
    for (int tm = 0; tm < 2; ++tm)
#pragma unroll
      for (int tn = 0; tn < 2; ++tn)
#pragma unroll
        for (int r = 0; r < 16; ++r) {
          int cl = 64 * wn + 32 * tn + l31e;
          if (J.aux & 1) cl = (cl & ~12) | ((cl & 4) << 1) | ((cl & 8) >> 1);
          *(bf16_t*)(img + (64 * wm + 32 * tm + crow(r, hie)) * IST + cl * 2) = f2bf(acc[tm][tn][r]);
        }
    obase = (bf16_t*)J.out + (size_t)J.m0 * J.ldc + J.n0; oldc = J.ldc;
  } else if (J.epi == EPI_ROPE_RET_N) {
    const int g128 = n0w >> 7, fi = 32 * wn + l31e;
#pragma unroll
    for (int tm = 0; tm < 2; ++tm)
#pragma unroll
      for (int r = 0; r < 16; ++r) {
        const int rl = 64 * wm + 32 * tm + crow(r, hie), row = J.m0 + rl;
        float x1 = acc[tm][0][r], x2 = acc[tm][1][r];
        if (row < TL) { const int pos = (g128 & 1) ? (row & 63) : ((row >> 6) & 63); const f32x2 cs = rope_cs(pos, fi, 13.287712379549449f / 64.f); const float y1 = x1 * cs.x - x2 * cs.y, y2 = x1 * cs.y + x2 * cs.x; x1 = y1; x2 = y2; }
        *(bf16_t*)(img + rl * IST + fi * 2) = f2bf(x1 * J.scale); *(bf16_t*)(img + rl * IST + (fi + 64) * 2) = f2bf(x2 * J.scale);
      }
    obase = (bf16_t*)J.out + (size_t)J.m0 * 1024 + J.n0; oldc = 1024;
  } else if (J.epi == EPI_ROPE_RET_T) {
    const int g128 = m0w >> 7;
#pragma unroll
    for (int tn = 0; tn < 2; ++tn) {
      const int cl = 64 * wn + 32 * tn + l31e, tok = J.n0 + cl; const int pos = (g128 & 1) ? (tok & 63) : ((tok >> 6) & 63);
#pragma unroll
      for (int r = 0; r < 16; ++r) {
        const int fi = 32 * wm + crow(r, hie);
        float x1 = acc[0][tn][r], x2 = acc[1][tn][r];
        if (tok < TL) { const f32x2 cs = rope_cs(pos, fi, 13.287712379549449f / 64.f); const float y1 = x1 * cs.x - x2 * cs.y, y2 = x1 * cs.y + x2 * cs.x; x1 = y1; x2 = y2; }
        *(bf16_t*)(img + fi * IST + cl * 2) = f2bf(x1 * J.scale); *(bf16_t*)(img + (fi + 64) * IST + cl * 2) = f2bf(x2 * J.scale);
      }
    }
    obase = (bf16_t*)J.out + (size_t)J.m0 * T + J.n0; oldc = T;
  } else if (J.epi == EPI_ROPE_DIFF_N) {
    const int fi = l31e & 15, c1 = 64 * wn + (l31e < 16 ? l31e : l31e + 16);
#pragma unroll
    for (int tm = 0; tm < 2; ++tm)
#pragma unroll
      for (int r = 0; r < 16; ++r) {
        const int rl = 64 * wm + 32 * tm + crow(r, hie), row = J.m0 + rl;
        float x1 = acc[tm][0][r], x2 = acc[tm][1][r];
        if (row < TL) { const int pos = (l31e < 16) ? ((row >> 6) & 63) : (row & 63); const f32x2 cs = rope_cs(pos, fi, 13.287712379549449f / 16.f); const float y1 = x1 * cs.x - x2 * cs.y, y2 = x1 * cs.y + x2 * cs.x; x1 = y1; x2 = y2; }
        *(bf16_t*)(img + rl * IST + c1 * 2) = f2bf(x1); *(bf16_t*)(img + rl * IST + (c1 + 16) * 2) = f2bf(x2);
      }
    obase = (bf16_t*)J.out + (size_t)J.m0 * 1024 + J.n0; oldc = 1024;
  } else if (J.epi == EPI_SMASK) {
    const int il4 = J.aux, hh = il4 & 3;
    const float lgf = -log2f(1.f + expf(-P.ret_df[il4])), lgb = -log2f(1.f + expf(-P.ret_db[il4]));
#pragma unroll
    for (int d = 0; d < 2; ++d) {
#pragma unroll
      for (int tm = 0; tm < 2; ++tm)
#pragma unroll
        for (int tn = 0; tn < 2; ++tn)
#pragma unroll
          for (int r = 0; r < 16; ++r) {
            const int i = 64 * wm + 32 * tm + crow(r, hie), j = 64 * wn + 32 * tn + l31e, dd = d ? j - i : i - j;
            const float v = dd >= 0 ? acc[tm][tn][r] * ex2((d ? lgb : lgf) * (float)dd) : 0.f;
            *(bf16_t*)(img + i * IST + j * 2) = f2bf(v);
          }
      __syncthreads();
      bf16_t* ob2 = (bf16_t*)J.out + (size_t)J.m0 * 1024 + hh * 256 + d * 128;
#pragma unroll
      for (int i = 0; i < 8; ++i) { const int c = tid + 256 * i, row = c >> 4, cc = c & 15, hb = ((d * 4 + (row >> 5)) * 8 + (cc >> 1)) * 2 + (cc & 1);
        *(u32x4*)((bf16_t*)J.out + (size_t)(J.m0 + hb) * 1024 + hh * 256 + (row & 31) * 8) = *(const u32x4*)(img + row * IST + cc * 16); }
      __syncthreads();
    }
    return;
  } else if (J.epi == EPI_ACT) {
#pragma unroll
    for (int tm = 0; tm < 2; ++tm)
#pragma unroll
      for (int tn = 0; tn < 2; ++tn)
#pragma unroll
        for (int r = 0; r < 16; ++r) *(bf16_t*)(img + (64 * wm + 32 * tm + crow(r, hie)) * IST + (64 * wn + 32 * tn + l31e) * 2) = f2bf(acc[tm][tn][r]);
    __syncthreads();
    {
      const int ch = tid & 7, rg = tid >> 3, f0 = 64 * (J.n0 >> 7) + 8 * ch;
      const float* cw = P.ffn_cw + (size_t)J.aux * 3 * 2816; const float* cb = P.ffn_cb + (size_t)J.aux * 2816;
      float w0[8], w1[8], w2[8], bb[8];
#pragma unroll
      for (int j = 0; j < 8; ++j) { w0[j] = cw[f0 + j]; w1[j] = cw[2816 + f0 + j]; w2[j] = cw[5632 + f0 + j]; bb[j] = cb[f0 + j]; }
      const int slen = J.m0 < TL ? 4096 : 256, p0 = J.m0 < TL ? (J.m0 & 4095) : ((J.m0 - TL) & 255);
      const bool sstart = p0 == 0, send = p0 + 128 == slen;
      u32x4 g[6], vv[4];
#pragma unroll
      for (int qd = 0; qd < 6; ++qd) { const int lr = 4 * rg - 1 + qd; g[qd] = (u32x4){0, 0, 0, 0}; if (lr >= 0 && lr < 128) g[qd] = *(const u32x4*)(img + lr * IST + (64 + 8 * ch) * 2); }
#pragma unroll
      for (int qd = 0; qd < 4; ++qd) vv[qd] = *(const u32x4*)(img + (4 * rg + qd) * IST + 8 * ch * 2);
      bf16_t* aout = (bf16_t*)J.out; bf16_t* vgb = (bf16_t*)(P.ws + OFF_AR);
#pragma unroll
      for (int qd = 0; qd < 4; ++qd) {
        const int lr = 4 * rg + qd;
        float o[8];
#pragma unroll
        for (int k2 = 0; k2 < 4; ++k2) {
          const float x0 = w0[2 * k2] * bflo(g[qd][k2]) + w1[2 * k2] * bflo(g[qd + 1][k2]) + w2[2 * k2] * bflo(g[qd + 2][k2]) + bb[2 * k2];
          const float x1 = w0[2 * k2 + 1] * bfhi(g[qd][k2]) + w1[2 * k2 + 1] * bfhi(g[qd + 1][k2]) + w2[2 * k2 + 1] * bfhi(g[qd + 2][k2]) + bb[2 * k2 + 1];
          o[2 * k2] = siluf(x0) * bflo(vv[qd][k2]); o[2 * k2 + 1] = siluf(x1) * bfhi(vv[qd][k2]);
        }
        if ((lr > 0 || sstart) && (lr < 127 || send)) {
          u32x4 ov; ov.x = pk2(o[0], o[1]); ov.y = pk2(o[2], o[3]); ov.z = pk2(o[4], o[5]); ov.w = pk2(o[6], o[7]);
          *(u32x4*)(aout + (size_t)(J.m0 + lr) * 2816 + f0) = ov;
        }
        if (lr < 2 || lr > 125) {
          *(u32x4*)(vgb + (size_t)(J.m0 + lr) * 5632 + f0) = vv[qd];
          *(u32x4*)(vgb + (size_t)(J.m0 + lr) * 5632 + 2816 + f0) = g[qd + 1];
        }
      }
    }
    __syncthreads();
    return;
  } else {
    constexpr int MST = 144;
    char* oft = lds + 18432; char* obt = lds + 36864; float* rs = (float*)(lds + 55296);
    const int f0 = J.n0 >> 1, hd = f0 >> 9;
    const bf16_t* of = (const bf16_t*)(P.ws + OFF_AR + 5 * SZ_U); const bf16_t* ob = (const bf16_t*)(P.ws + OFF_AR + 7 * SZ_U);
    {
      const int row = tid & 127, dir = tid >> 7;
      const float* sp = (const float*)(P.ws + OFF_SSQ) + (dir ? (size_t)T * 64 : 0) + ((size_t)(J.m0 + row) * 4 + hd) * 16;
      float sm = 0.f;
#pragma unroll
      for (int qd = 0; qd < 4; ++qd) { const f32x4 pv = *(const f32x4*)(sp + 4 * qd); sm += (pv.x + pv.y) + (pv.z + pv.w); }
      rs[tid] = rsqrtf(sm * (1.f / 512.f) + EPS);
#pragma unroll
      for (int i = 0; i < 4; ++i) {
        const int c = tid + 256 * i, r2 = c >> 3, cc = c & 7;
        *(u32x4*)(oft + r2 * MST + cc * 16) = *(const u32x4*)(of + (size_t)(J.m0 + r2) * 2048 + f0 + cc * 8);
        *(u32x4*)(obt + r2 * MST + cc * 16) = *(const u32x4*)(ob + (size_t)(J.m0 + r2) * 2048 + f0 + cc * 8);
      }
    }
    __syncthreads();
    const int cl = 32 * wn + l31e;
#pragma unroll
    for (int tm = 0; tm < 2; ++tm)
#pragma unroll
      for (int r = 0; r < 16; ++r) {
        const int rl = 64 * wm + 32 * tm + crow(r, hie);
        const float vf = bf2f(*(const bf16_t*)(oft + rl * MST + cl * 2)) * rs[rl], vb = bf2f(*(const bf16_t*)(obt + rl * MST + cl * 2)) * rs[128 + rl];
        *(bf16_t*)(img + rl * MST + cl * 2) = f2bf(siluf(acc[tm][0][r]) * vf + siluf(acc[tm][1][r]) * vb);
      }
    obase = (bf16_t*)J.out + (size_t)J.m0 * 2048 + f0; oldc = 2048; ocols = 64; ist = MST;
  }
  __syncthreads();
  if (ocols == 128 && (J.aux & 2)) {
    const int ci = J.n0 >> 7;
#pragma unroll
    for (int i = 0; i < 8; ++i) {
      const int c = tid + 256 * i, row = c >> 4, cc = c & 15, gt = (J.m0 + row) >> 5;
      bf16_t* dst = (bf16_t*)J.out + ((((size_t)gt * 136 + ci) * 8 + (cc >> 1)) * 64 + (cc & 1) * 32 + (row & 31)) * 8;
      *(u32x4*)dst = *(const u32x4*)(img + row * ist + cc * 16);
    }
  } else if (ocols == 128 && (J.aux & 8)) {
    const int hq = J.n0 >> 8, s0 = ((J.n0 >> 7) & 1) * 8;
#pragma unroll
    for (int i = 0; i < 8; ++i) {
      const int c = tid + 256 * i, row = c >> 4, cc = c & 15, rt = (J.m0 + row) >> 5;
      bf16_t* dst = (bf16_t*)J.out + ((((size_t)rt * 4 + hq) * 16 + s0 + (cc >> 1)) * 64 + (cc & 1) * 32 + (row & 31)) * 8;
      *(u32x4*)dst = *(const u32x4*)(img + row * ist + cc * 16);
    }
  } else if (ocols == 128) {
#pragma unroll
    for (int i = 0; i < 8; ++i) { const int c = tid + 256 * i, row = c >> 4, cc = c & 15; *(u32x4*)(obase + (size_t)row * oldc + cc * 8) = *(const u32x4*)(img + row * ist + cc * 16); }
  } else {
#pragma unroll
    for (int i = 0; i < 4; ++i) { const int c = tid + 256 * i, row = c >> 3, cc = c & 7; *(u32x4*)(obase + (size_t)row * oldc + cc * 8) = *(const u32x4*)(img + row * ist + cc * 16); }
  }
  if (J.aux & 32) {
    bf16_t* ktf = (bf16_t*)(P.ws + OFF_AR + 2 * SZ_U);
    const int ci = J.m0 >> 7;
#pragma unroll
    for (int i = 0; i < 8; ++i) {
      const int c = tid + 256 * i, dl = c & 127, jc = c >> 7;
      const char* src = img + (8 * jc) * ist + dl * 2;
      u32x4 v;
      v.x = (unsigned)*(const bf16_t*)(src) | ((unsigned)*(const bf16_t*)(src + ist) << 16);
      v.y = (unsigned)*(const bf16_t*)(src + 2 * ist) | ((unsigned)*(const bf16_t*)(src + 3 * ist) << 16);
      v.z = (unsigned)*(const bf16_t*)(src + 4 * ist) | ((unsigned)*(const bf16_t*)(src + 5 * ist) << 16);
      v.w = (unsigned)*(const bf16_t*)(src + 6 * ist) | ((unsigned)*(const bf16_t*)(src + 7 * ist) << 16);
      bf16_t* dst = ktf + (((((size_t)((J.n0 + dl) >> 5) * 136 + ci) * 8 + (jc >> 1)) * 64) + (jc & 1) * 32 + (dl & 31)) * 8;
      *(u32x4*)dst = v;
    }
  }
  __syncthreads();
}

DI void tile_mn(int idx, int nN, int& tm, int& tn) { const int per = 8 * nN, mg = idx / per, rem = idx % per; tn = rem >> 3; tm = mg * 8 + (rem & 7); }

enum { GP_RET_IN = 0, GP_RET_GATE, GP_RET_OUT, GP_DIFF_IN, GP_DIFF_OUT, GP_FFN_UP, GP_FFN_DOWN, GP_RET_S };
DI void gemm_phase(const Params& P, int kind, char* lds, int layer, int wid_s) {
  const bf16_t* U = (const bf16_t*)(P.ws + OFF_U); const bf16_t* WM = (const bf16_t*)(P.ws + OFF_WM); const bf16_t* WF = (const bf16_t*)(P.ws + OFF_WF);
  char* AR = P.ws + OFF_AR;
  int total;
  switch (kind) {
    case GP_RET_IN: total = 1088 * 4; break;
    case GP_RET_S: total = 544; break;
    case GP_RET_GATE: total = 136 * 32; break;
    case GP_DIFF_IN: total = 1088 * 3; break;
    case GP_FFN_UP: total = (layer == 3 ? 128 : 136) * 44; break;
    default: total = layer == 3 ? 1024 : 1024 + 256; break;
  }
  const int G = gridDim.x, per = G >> 3; const int tid = otid();
  for (int base = 0; base < total; base += G) {
    int L = base + ((G & 7) == 0 ? (int)(blockIdx.x & 7) * per + (int)(blockIdx.x >> 3) : (int)blockIdx.x);
    if (L >= total) continue;
    if (kind == GP_DIFF_IN && layer == 3 && L >= 1024 && L < 1088) continue;
    Job J; J.lda = 1024; J.ldb = 1024; J.K = 1024; J.scale = 1.f; J.ldc = 1024; J.aux = 0; J.afrag = 0;
    int tm, tn;
    if (kind == GP_RET_S) { const int hh = L & 3, ci = L >> 2; tm = ci; tn = ci; J.A = (const bf16_t*)AR; J.afrag = 1 + hh; J.B = (const bf16_t*)(AR + SZ_U) + hh * 256; J.K = 256; J.epi = EPI_SMASK; J.out = AR + SZ_U; J.aux = (layer >> 1) * 4 + hh; }
    else if (kind == GP_RET_IN) {
      if (L < 1088) { tile_mn(L, 8, tm, tn); J.A = U; J.B = WM; J.epi = EPI_ROPE_RET_N; J.out = AR; J.aux = 8; }
      else if (L < 2176) { tile_mn(L - 1088, 8, tm, tn); J.A = U; J.B = WM + (size_t)1024 * 1024; J.epi = EPI_ROPE_RET_N; J.out = AR + SZ_U; J.scale = 0.0625f; J.aux = 32; }
      else { tile_mn(L - 2176, 136, tm, tn); J.A = WM + (size_t)2048 * 1024; J.B = U; J.epi = EPI_BF16; J.out = AR + 3 * SZ_U; J.ldc = T; J.aux = 2; }
    } else if (kind == GP_RET_GATE) { tile_mn(L, 32, tm, tn); J.A = U; J.B = WM + (size_t)4096 * 1024; J.epi = EPI_MERGE; J.out = AR; }
    else if (kind == GP_RET_OUT) { tile_mn(L < 1024 ? L : 1024 + ((L - 1024) >> 2), 8, tm, tn); J.A = (const bf16_t*)AR; J.lda = 2048; J.B = WM + (size_t)8192 * 1024; J.ldb = 2048; J.K = 2048; J.epi = EPI_BF16; J.out = AR + 3 * SZ_U; }
    else if (kind == GP_DIFF_IN) {
      if (L < 1088) { tile_mn(L, 8, tm, tn); J.A = U; J.B = WM; J.epi = EPI_ROPE_DIFF_N; J.out = AR; }
      else if (L < 2176) { tile_mn(L - 1088, 8, tm, tn); J.A = U; J.B = WM + (size_t)1024 * 1024; J.epi = EPI_ROPE_DIFF_N; J.out = AR + SZ_U; }
      else { tile_mn(L - 2176, 136, tm, tn); J.A = WM + (size_t)2048 * 1024; J.B = U; J.epi = EPI_BF16; J.out = AR + 2 * SZ_U; J.ldc = T; J.aux = 1; }
    } else if (kind == GP_DIFF_OUT) { tile_mn(L < 1024 ? L : 1024 + ((L - 1024) >> 2), 8, tm, tn); J.A = (const bf16_t*)(AR + 5 * SZ_U); J.B = WM + (size_t)3072 * 1024; J.epi = EPI_BF16; J.out = AR + 3 * SZ_U; }
    else if (kind == GP_FFN_UP) { tile_mn(L, 44, tm, tn); J.A = U; J.B = WF; J.epi = EPI_ACT; J.out = AR + 6 * SZ_U; J.aux = layer; }
    else { tile_mn(L < 1024 ? L : 1024 + ((L - 1024) >> 2), 8, tm, tn); J.A = (const bf16_t*)(AR + 6 * SZ_U); J.lda = 2816; J.B = WF + (size_t)5632 * 1024; J.ldb = 2816; J.K = 2816; J.epi = EPI_BF16; J.out = AR; }
    if ((kind == GP_RET_OUT || kind == GP_DIFF_OUT || kind == GP_FFN_DOWN) && L >= 1024) {
      const int kp = (L - 1024) & 3, kq = J.K >> 2;
      J.A += kp * kq; J.B += kp * kq; J.K = kq; J.epi = EPI_F32; J.ldc = 1024;
      J.out = (float*)(AR + 4 * SZ_U) + (size_t)kp * 1024 * 1024 - (size_t)TL * 1024;
    }
    J.m0 = tm * 128; J.n0 = tn * 128;
    gemm_tile(P, J, lds, tid);
  }
}

DI void write_rt(const f32x16 (&accR)[2], char* lds, int w, int l31, int hi) {
#pragma unroll
  for (int td = 0; td < 2; ++td)
#pragma unroll
    for (int g = 0; g < 4; ++g) {
      const int d = 64 * w + 32 * td + 8 * g + 4 * hi, v = l31;
      u32x2 pk; pk.x = pk2(accR[td][4 * g], accR[td][4 * g + 1]); pk.y = pk2(accR[td][4 * g + 2], accR[td][4 * g + 3]);
      *(u32x2*)(lds + v * 512 + (((d >> 3) ^ (v & 15)) << 4) + (d & 7) * 2) = pk;
    }
}
DI int ret_r0(int cc, int dir, int b) { return cc < 2 ? TL + b * 256 + 128 * (dir ? 1 - cc : cc) : b * 4096 + 128 * (dir ? 33 - cc : cc - 2); }
DI void ret_phase(const Params& P, int l, char* lds, int wid_s) {
  const int tid = otid(), lane = tid & 63, w = tid >> 6, l31 = lane & 31, hi = lane >> 5, il = l >> 1;
  const char* q = P.ws + OFF_AR; const char* pd = P.ws + OFF_AR + SZ_U;
  const char* kT = P.ws + OFF_AR + 2 * SZ_U; const char* vT = P.ws + OFF_AR + 3 * SZ_U;
  for (int item = blockIdx.x; item < 512; item += gridDim.x) {
    const int dvs = item & 15, dir = (item >> 4) & 1, hh = (item >> 5) & 3, b = item >> 7;
    const float logit = (dir ? P.ret_db : P.ret_df)[il * 4 + hh];
    const float l2g = -log2f(1.f + expf(-logit));
    const float cdec = ex2(l2g * 128.f);
    const float gstep = ex2(dir ? l2g : -l2g);
    char* obuf = P.ws + OFF_AR + (dir ? 7 : 5) * SZ_U;
    float* ssq = (float*)(P.ws + OFF_SSQ) + (dir ? (size_t)T * 64 : 0);
    f32x16 accR[2];
#pragma unroll
    for (int a = 0; a < 2; ++a)
#pragma unroll
      for (int r = 0; r < 16; ++r) accR[a][r] = 0.f;
    __syncthreads();
    write_rt(accR, lds, w, l31, hi);
    __syncthreads();
    bf16x8 pa[8], bv[8], bq[16];
    {
      const int r0 = ret_r0(0, dir, b);
      const unsigned po = (unsigned)((((((r0 >> 5) + w) * 4 + hh) * 16) * 64) + lane) * 16u;
      const unsigned pf = (unsigned)((r0 + (dir * 4 + w) * 16 + hi) * 1024 + hh * 256 + l31 * 8) * 2u;
      const unsigned vo = (unsigned)((((hh * 16 + dvs) * 136 + (r0 >> 7)) * 8) * 64 + lane) * 16u;
#pragma unroll
      for (int s = 0; s < 8; ++s) { pa[s] = *(const bf16x8*)(pd + (pf + 4096u * s)); bv[s] = *(const bf16x8*)(vT + (vo + 1024u * s)); }
#pragma unroll
      for (int s = 0; s < 16; ++s) bq[s] = *(const bf16x8*)(q + (po + 1024u * s));
    }
    for (int cc = 0; cc < 34; ++cc) {
      float lg = l2g; int hiv = hi, l31v = l31; asm volatile("" : "+v"(lg), "+v"(hiv), "+v"(l31v));
      const int r0 = ret_r0(cc, dir, b);
      f32x16 accO, accQ;
#pragma unroll
      for (int r = 0; r < 16; ++r) { accO[r] = 0.f; accQ[r] = 0.f; }
#pragma unroll
      for (int s = 0; s < 8; ++s) accO = MFMA(pa[s], bv[s], accO);
#pragma unroll
      for (int s = 0; s < 16; ++s) { const bf16x8 br = *(const bf16x8*)(lds + (cc & 1) * 16384 + l31v * 512 + (((2 * s + hiv) ^ (l31v & 15)) << 4)); accQ = MFMA(bq[s], br, accQ); }
#pragma unroll
      for (int r = 0; r < 16; ++r) {
        const int i2 = 32 * w + crow(r, hiv); const float e = dir ? (float)(128 - i2) : (float)(i2 + 1);
        const float o = accO[r] + ex2(lg * e) * accQ[r];
        const int row = r0 + i2;
        *(bf16_t*)(obuf + (unsigned)(row * 2048 + hh * 512 + dvs * 32 + l31v) * 2u) = f2bf(o);
        float sq = o * o;
        sq = dpp_xadd<0xB1>(sq); sq = dpp_xadd<0x4E>(sq); sq = dpp_xadd<0x141>(sq); sq = dpp_xadd<0x140>(sq);
        sq += __shfl_xor(sq, 16);
        if (l31v == 0) ssq[(row * 4 + hh) * 16 + dvs] = sq;
      }
      __builtin_amdgcn_sched_barrier(0);
      bf16x8 ak[2][8];
      if (cc < 33) {
        const unsigned kto = (unsigned)((((hh * 8 + 2 * w) * 136 + (r0 >> 7)) * 8) * 64 + l31v + 32 * hiv) * 16u;
#pragma unroll
        for (int td = 0; td < 2; ++td)
#pragma unroll
          for (int s = 0; s < 8; ++s) ak[td][s] = *(const bf16x8*)(kT + (kto + (unsigned)(td * 136 * 8 * 64 * 16) + 1024u * s));
      }
      if (cc < 33) {
#pragma unroll
        for (int a = 0; a < 2; ++a)
#pragma unroll
          for (int r = 0; r < 16; ++r) accR[a][r] *= cdec;
#pragma unroll
        for (int s = 0; s < 8; ++s) {
          float z[8];
          { const int j0 = 16 * s + 8 * hiv; z[0] = ex2(lg * (float)(dir ? j0 : 127 - j0));
#pragma unroll
            for (int e = 1; e < 8; ++e) z[e] = z[e - 1] * gstep; }
          const u32x4 raw = __builtin_bit_cast(u32x4, bv[s]);
          u32x4 sc;
          sc.x = pk2(bflo(raw.x) * z[0], bfhi(raw.x) * z[1]); sc.y = pk2(bflo(raw.y) * z[2], bfhi(raw.y) * z[3]);
          sc.z = pk2(bflo(raw.z) * z[4], bfhi(raw.z) * z[5]); sc.w = pk2(bflo(raw.w) * z[6], bfhi(raw.w) * z[7]);
          const bf16x8 bvs = __builtin_bit_cast(bf16x8, sc);
          accR[0] = MFMA(ak[0][s], bvs, accR[0]); accR[1] = MFMA(ak[1][s], bvs, accR[1]);
        }
        const int r1 = ret_r0(cc + 1, dir, b);
        const unsigned po = (unsigned)((((((r1 >> 5) + w) * 4 + hh) * 16) * 64) + l31v + 32 * hiv) * 16u;
        const unsigned pf = (unsigned)((r1 + (dir * 4 + w) * 16 + hiv) * 1024 + hh * 256 + l31v * 8) * 2u;
        const unsigned vo = (unsigned)((((hh * 16 + dvs) * 136 + (r1 >> 7)) * 8) * 64 + l31v + 32 * hiv) * 16u;
#pragma unroll
        for (int s = 0; s < 8; ++s) { pa[s] = *(const bf16x8*)(pd + (pf + 4096u * s)); bv[s] = *(const bf16x8*)(vT + (vo + 1024u * s)); }
#pragma unroll
        for (int s = 0; s < 16; ++s) bq[s] = *(const bf16x8*)(q + (po + 1024u * s));
        __builtin_amdgcn_sched_barrier(0);
        write_rt(accR, lds + ((cc + 1) & 1) * 16384, w, l31v, hiv);
        __syncthreads();
      }
    }
  }
}

DI void att_phase(const Params& P, int l, char* lds, int wid_s) {
  const int tid = otid(), lane = tid & 63, w = tid >> 6, l31 = lane & 31, hi = lane >> 5, il = l >> 1;
  const bf16_t* q = (const bf16_t*)(P.ws + OFF_AR); const bf16_t* k = (const bf16_t*)(P.ws + OFF_AR + SZ_U);
  const bf16_t* vT = (const bf16_t*)(P.ws + OFF_AR + 2 * SZ_U); bf16_t* att = (bf16_t*)(P.ws + OFF_AR + 5 * SZ_U);
  const float csc = 0.125f * 1.4426950408889634f;
  for (int item = blockIdx.x; item < (l == 3 ? 1024 : 1024 + 64); item += gridDim.x) {
    int b, hh, R0, nt, nlat;
    if (item < 1024) { b = item >> 8; hh = (item >> 5) & 7; R0 = b * 4096 + 128 * (item & 31); nt = 68; nlat = 64; }
    else { const int i2 = item - 1024; b = i2 >> 4; hh = (i2 >> 1) & 7; R0 = TL + b * 256 + 128 * (i2 & 1); nt = 4; nlat = 0; }
    const int qrow = R0 + 32 * w + l31;
    bf16x8 bq[2][4];
#pragma unroll
    for (int r2 = 0; r2 < 2; ++r2)
#pragma unroll
      for (int s = 0; s < 4; ++s) bq[r2][s] = *(const bf16x8*)(q + (size_t)qrow * 1024 + hh * 128 + 64 * r2 + 16 * s + 8 * hi);
    f32x16 oT[2][4];
#pragma unroll
    for (int r2 = 0; r2 < 2; ++r2)
#pragma unroll
      for (int a = 0; a < 4; ++a)
#pragma unroll
        for (int r = 0; r < 16; ++r) oT[r2][a][r] = 0.f;
    float mrun[2] = {-1e30f, -1e30f}, lsum[2] = {0.f, 0.f};
    auto keybase = [&](int t) { return t < nlat ? b * 4096 + 64 * t : TL + b * 256 + 64 * (t - nlat); };
    auto dma = [&](int t, int buf) {
      int t2 = tid; asm volatile("" : "+v"(t2));
      const int kch = (t2 & 15) ^ ((t2 >> 4) & 15), krow_l = t2 >> 4;
      const int vch = (t2 & 7) ^ ((t2 >> 4) & 7), vrow_l = t2 >> 3;
      const int kb = keybase(t);
      const unsigned ko = (unsigned)((kb + krow_l) * 1024 + hh * 128 + kch * 8) * 2u;
      const unsigned vo = (unsigned)((hh * 128 + vrow_l) * T + kb + vch * 8) * 2u;
      char* kd = lds + buf * 16384 + t2 * 16; char* vd = lds + 32768 + buf * 16384 + t2 * 16;
#pragma unroll
      for (int i = 0; i < 4; ++i) {
        GLDS((const char*)k + (ko + (unsigned)(i * 16 * 1024 * 2)), kd + i * 4096);
        GLDS((const char*)vT + (vo + (unsigned)(i * 32 * T * 2)), vd + i * 4096);
      }
    };
    __syncthreads();
    dma(0, 0);
    asm volatile("s_waitcnt vmcnt(0)" ::: "memory");
    __syncthreads();
    for (int t = 0; t < nt; ++t) {
      const char* kb_ = lds + (t & 1) * 16384; const char* vb_ = lds + 32768 + (t & 1) * 16384;
      if (t + 1 < nt) dma(t + 1, (t + 1) & 1);
#pragma unroll
      for (int r2 = 0; r2 < 2; ++r2) {
        int l31v = l31, hiv = hi; asm volatile("" : "+v"(l31v), "+v"(hiv));
        f32x16 st[2];
#pragma unroll
        for (int jt = 0; jt < 2; ++jt) {
#pragma unroll
          for (int r = 0; r < 16; ++r) st[jt][r] = 0.f;
          const int row = 32 * jt + l31v;
#pragma unroll
          for (int s = 0; s < 4; ++s) { const bf16x8 ak = *(const bf16x8*)(kb_ + row * 256 + (((8 * r2 + 2 * s + hiv) ^ (row & 15)) << 4)); st[jt] = MFMA(ak, bq[r2][s], st[jt]); }
        }
        float mx = st[0][0];
#pragma unroll
        for (int r = 1; r < 16; ++r) mx = fmaxf(mx, st[0][r]);
#pragma unroll
        for (int r = 0; r < 16; ++r) mx = fmaxf(mx, st[1][r]);
        mx = fmaxf(mx, __shfl_xor(mx, 32));
        const float mnew = fmaxf(mrun[r2], mx * csc), alpha = ex2(mrun[r2] - mnew);
        mrun[r2] = mnew;
        float ps = 0.f;
#pragma unroll
        for (int jt = 0; jt < 2; ++jt)
#pragma unroll
          for (int r = 0; r < 16; ++r) { const float p = ex2(st[jt][r] * csc - mnew); st[jt][r] = p; ps += p; }
        lsum[r2] = lsum[r2] * alpha + ps;
#pragma unroll
        for (int a = 0; a < 4; ++a)
#pragma unroll
          for (int r = 0; r < 16; ++r) oT[r2][a][r] *= alpha;
#pragma unroll
        for (int jt = 0; jt < 2; ++jt)
#pragma unroll
          for (int s2 = 0; s2 < 2; ++s2) {
            const bf16x8 pb = pack8(st[jt], s2);
            const int chunk = 4 * jt + 2 * s2 + hiv;
#pragma unroll
            for (int tv = 0; tv < 4; ++tv) {
              const int v = 32 * tv + l31v, sw = (v >> 1) & 7;
              const bf16x8 av = *(const bf16x8*)(vb_ + v * 128 + ((chunk ^ sw) << 4));
              oT[r2][tv] = MFMA(av, pb, oT[r2][tv]);
              if (tv & 1) __builtin_amdgcn_sched_barrier(0);
            }
          }
      }
      asm volatile("s_waitcnt vmcnt(0)" ::: "memory");
      __syncthreads();
    }
    lsum[0] += __shfl_xor(lsum[0], 32); lsum[1] += __shfl_xor(lsum[1], 32);
    int lv = l; asm volatile("" : "+s"(lv));
    const float lam_init = (lv == 1) ? 0.3555090676f : 0.5560582042f;
    float d1 = 0.f, d2 = 0.f;
    for (int e = 0; e < 64; ++e) { d1 += P.lq1[il * 64 + e] * P.lk1[il * 64 + e]; d2 += P.lq2[il * 64 + e] * P.lk2[il * 64 + e]; }
    const float lam = ex2(d1 * 1.4426950408889634f) - ex2(d2 * 1.4426950408889634f) + lam_init;
    const float inv0 = __builtin_amdgcn_rcpf(lsum[0]), inv1 = lam * __builtin_amdgcn_rcpf(lsum[1]);
    float ss = 0.f;
#pragma unroll
    for (int a = 0; a < 4; ++a)
#pragma unroll
      for (int r = 0; r < 16; ++r) { const float o = oT[0][a][r] * inv0 - oT[1][a][r] * inv1; oT[0][a][r] = o; ss += o * o; }
    ss += __shfl_xor(ss, 32);
    const float rstd = __builtin_amdgcn_rsqf(ss * (1.f / 128.f) + EPS) * (1.f - lam_init);
    const float* sg = P.subln + il * 128;
    int t3 = tid; asm volatile("" : "+v"(t3));
    const int qrow2 = R0 + 32 * (t3 >> 6) + (t3 & 31), hi3 = (t3 >> 5) & 1;
#pragma unroll
    for (int a = 0; a < 4; ++a)
#pragma unroll
      for (int g = 0; g < 4; ++g) {
        const int v = 32 * a + 8 * g + 4 * hi3;
        const f32x4 gg = *(const f32x4*)(sg + v);
        u32x2 pk; pk.x = pk2(oT[0][a][4 * g] * rstd * gg.x, oT[0][a][4 * g + 1] * rstd * gg.y); pk.y = pk2(oT[0][a][4 * g + 2] * rstd * gg.z, oT[0][a][4 * g + 3] * rstd * gg.w);
        *(u32x2*)(att + (size_t)qrow2 * 1024 + hh * 128 + v) = pk;
      }
  }
}

__global__ void __launch_bounds__(NTH, 2) fwd_kernel(Params P) {
  __shared__ __attribute__((aligned(16))) char lds[65536];
  cg::grid_group grid = cg::this_grid();
  int ph = 0;
  __shared__ unsigned xb_st[4];
  const int wid_s = __builtin_amdgcn_readfirstlane((int)threadIdx.x >> 6);
  if (wid_s == 0 && lane_id() < 4) xb_st[lane_id()] = 0u;
  __syncthreads();
  const XcdBarrier xb = xcd_barrier_post((unsigned*)(P.ws + OFF_BAR), (volatile LAS unsigned*)xb_st, wid_s);
  const bf16_t* ymix = (const bf16_t*)(P.ws + OFF_AR + 3 * SZ_U); const bf16_t* yffn = (const bf16_t*)(P.ws + OFF_AR);
#define PHASE_BEGIN if (ph >= P.lo && ph < P.hi) {
#define PHASE_END if (ph + 1 < P.hi) { if (P.lo < 0) grid.sync(); xcd_barrier(xb, wid_s); } } ++ph;
#ifndef PH_MASK
#define PH_MASK 0xffff
#endif
#define HAS(n) ((PH_MASK >> (n)) & 1)
#ifndef REP
#define REP 0
#endif
#define NREP(n) (((REP >> (n)) & 1) ? 2 : 1)
  PHASE_BEGIN
#if HAS(0)
    for (int rr = 0; rr < NREP(0); ++rr) mod_phase(P, lds, wid_s);
#endif
#if HAS(1)
    for (int rr = 0; rr < NREP(1); ++rr) { int base = 384; conv_mixer(P, 0, lds, base, wid_s); conv_ffn(P, 0, lds, base, wid_s); }
#endif
  PHASE_END
  for (int l = 0; l < 4; ++l) {
    const bool ret = (l & 1) == 0;
    PHASE_BEGIN
#if HAS(2)
      if (l == 0) pn_phase(P, -1, 0, 0, 0, true, nullptr, wid_s); else pn_phase(P, l - 1, 1, l, 0, false, yffn, wid_s);
#endif
#if HAS(1)
      if (l > 0) for (int rr = 0; rr < NREP(1); ++rr) { int base = 0; conv_ffn(P, l, lds, base, wid_s); }
#endif
    PHASE_END
    PHASE_BEGIN
#if HAS(3)
      for (int rr = 0; rr < NREP(3); ++rr) gemm_phase(P, ret ? GP_RET_IN : GP_DIFF_IN, lds, l, wid_s);
#endif
    PHASE_END
    if (ret) { PHASE_BEGIN
#if HAS(3)
      gemm_phase(P, GP_RET_S, lds, l, wid_s);
#endif
    PHASE_END }
    PHASE_BEGIN
#if HAS(4)
      if (ret) for (int rr = 0; rr < NREP(4); ++rr) ret_phase(P, l, lds, wid_s);
#endif
#if HAS(5)
      if (!ret) for (int rr = 0; rr < NREP(5); ++rr) att_phase(P, l, lds, wid_s);
#endif
    PHASE_END
    if (ret) { PHASE_BEGIN
#if HAS(3)
      for (int rr = 0; rr < NREP(3); ++rr) gemm_phase(P, GP_RET_GATE, lds, l, wid_s);
#endif
    PHASE_END }
    PHASE_BEGIN
#if HAS(3)
      for (int rr = 0; rr < NREP(3); ++rr) gemm_phase(P, ret ? GP_RET_OUT : GP_DIFF_OUT, lds, l, wid_s);
#endif
    PHASE_END
    PHASE_BEGIN
#if HAS(2)
      pn_phase(P, l, 0, l, 1, l == 0, ymix, wid_s);
#endif
#if HAS(1)
      if (l < 3) for (int rr = 0; rr < NREP(1); ++rr) { int base = 0; conv_mixer(P, l + 1, lds, base, wid_s); }
#endif
    PHASE_END
    PHASE_BEGIN
#if HAS(3)
      for (int rr = 0; rr < NREP(3); ++rr) gemm_phase(P, GP_FFN_UP, lds, l, wid_s);
#endif
    PHASE_END
    PHASE_BEGIN
#if HAS(6)
      for (int rr = 0; rr < NREP(6); ++rr) act_phase(P, l, wid_s);
#endif
    PHASE_END
    PHASE_BEGIN
#if HAS(3)
      for (int rr = 0; rr < NREP(3); ++rr) gemm_phase(P, GP_FFN_DOWN, lds, l, wid_s);
#endif
    PHASE_END
  }
  PHASE_BEGIN
#if HAS(2)
    pn_phase(P, 3, 1, -1, 0, false, yffn, wid_s);
#endif
  PHASE_END
}
constexpr int N_PHASES = 1 + 10 + 8 + 10 + 8 + 1;
#ifdef STOP_AT
__global__ void dump_kernel(const unsigned short* ws, float* out, size_t nws16) {
  size_t i = (size_t)blockIdx.x * 256 + threadIdx.x;
  unsigned acc = 0;
  for (size_t j = i; j < nws16; j += (size_t)TL * 1024) acc = acc * 31u + ws[j];
  out[i] = (float)(acc & 0xFFFFu) * (1.f / 65536.f);
}
#endif

extern "C" void kernel_launch(void* const* d_in, const int* in_sizes, int n_in, void* d_out, int out_size, void* d_ws, size_t ws_size, hipStream_t stream) {
  static int grid_blocks = 0;
  if (!grid_blocks) {
    int dev = 0, cus = 0, per_cu = 0;
    hipGetDevice(&dev);
    hipDeviceGetAttribute(&cus, hipDeviceAttributeMultiprocessorCount, dev);
    hipOccupancyMaxActiveBlocksPerMultiprocessor(&per_cu, fwd_kernel, NTH, 0);
    if (per_cu > 2) per_cu = 2;
    if (per_cu < 1) per_cu = 1;
    grid_blocks = cus * per_cu;
  }
  if (ws_size < WS_NEED) fprintf(stderr, "workspace too small: %zu < %zu\n", ws_size, (size_t)WS_NEED);
  Params p{};
  const float** f = (const float**)&p;
  for (int i = 0; i < 22; ++i) f[i] = (const float*)d_in[i];
  p.out = (float*)d_out; p.ws = (char*)d_ws;
#if MULTI_LAUNCH
#ifdef STOP_AT
  for (int ph = 0; ph < STOP_AT; ++ph) { p.lo = ph; p.hi = ph + 1; hipLaunchKernelGGL(fwd_kernel, dim3(grid_blocks), dim3(NTH), 0, stream, p); }
  hipLaunchKernelGGL(dump_kernel, dim3(TL * 1024 / 256), dim3(256), 0, stream, (const unsigned short*)d_ws, (float*)d_out, (size_t)WS_NEED / 2);
#else
  for (int ph = 0; ph < N_PHASES; ++ph) { p.lo = ph; p.hi = ph + 1; hipLaunchKernelGGL(fwd_kernel, dim3(grid_blocks), dim3(NTH), 0, stream, p); }
#endif
#else
  p.lo = 0; p.hi = N_PHASES;
  hipMemsetAsync((char*)d_ws + OFF_BAR, 0, 16384, stream);
  void* args[] = {&p};
  hipError_t e = hipLaunchCooperativeKernel((void*)fwd_kernel, dim3(grid_blocks), dim3(NTH), args, 0, stream);
  if (e != hipSuccess) fprintf(stderr, "cooperative launch failed: %s (grid %d)\n", hipGetErrorString(e), grid_blocks);
#endif
}
```
